# Optimizing an MI355X kernel written in HIP

```python
import math
import jax, jax.numpy as jnp
from jax import lax
import numpy as np

D_MODEL = 1024
BATCH = 8
SEQ = 4096
DEPTH = 1

GRID_W = 64
CTX_LEN = 256
NA_HEADS = 8
NA_HEAD_DIM = 64
NA_WIN_H = 8
NA_WIN_W = 16
RET_HEADS = 4
RET_QK_DIM = 128
RET_V_DIM = 256
RET_CHUNK = 128
D_FF = int(math.ceil(8 * D_MODEL / 3 / 128)) * 128
CONV_W = 3
ROPE_BASE = 10000.0
EPS = 1e-6

NA_W = NA_HEADS * NA_HEAD_DIM
RET_QK_W = RET_HEADS * RET_QK_DIM
RET_V_W = RET_HEADS * RET_V_DIM
IN_SPLITS = [NA_W, NA_W, NA_W, RET_QK_W, RET_QK_W, RET_V_W, RET_V_W, D_MODEL, D_MODEL]
IN_COLS = sum(IN_SPLITS)
IN_OFFSETS = [int(o) for o in np.cumsum(IN_SPLITS)[:-1]]

kernel_name = "hybrid_natten_retention_convffn_dit"


def _rmsnorm(x, g):
    xf = x.astype(jnp.float32)
    y = xf * lax.rsqrt(jnp.mean(xf * xf, axis=-1, keepdims=True) + EPS)
    return y.astype(x.dtype) * g


def _modulate(h, shift, scale):
    return h * (1.0 + scale) + shift


def _heads(t, n_heads):
    b, n, _ = t.shape
    return t.reshape(b, n, n_heads, -1).transpose(0, 2, 1, 3)


def _merge_heads(t):
    b, h, n, d = t.shape
    return t.transpose(0, 2, 1, 3).reshape(b, n, h * d)


def _rope_axis(t, pos):
    nf = t.shape[-1] // 2
    inv = ROPE_BASE ** (-jnp.arange(nf, dtype=jnp.float32) / nf)
    ang = pos.astype(jnp.float32)[:, None] * inv[None, :]
    cos = jnp.cos(ang).astype(t.dtype)
    sin = jnp.sin(ang).astype(t.dtype)
    t1, t2 = t[..., :nf], t[..., nf:]
    return jnp.concatenate([t1 * cos - t2 * sin, t1 * sin + t2 * cos], axis=-1)


def _rope2d(t, rows, cols):
    half = t.shape[-1] // 2
    return jnp.concatenate([_rope_axis(t[..., :half], rows), _rope_axis(t[..., half:], cols)], axis=-1)


def _na_latent(q, k, v, kc, vc, rpb):
    b, h, n_rows, w, hd = q.shape
    kh = min(NA_WIN_H, n_rows)
    kw = NA_WIN_W
    cols = np.arange(w)
    c_start = np.clip(cols - kw // 2, 0, w - kw)
    cidx = c_start[:, None] + np.arange(kw)[None, :]
    dc = cidx - cols[:, None] + (NA_WIN_W - 1)
    qs = q * (hd ** -0.5)

    def row_block(r):
        r_start = jnp.clip(r - kh // 2, 0, n_rows - kh)
        kb = lax.dynamic_slice_in_dim(k, r_start, kh, axis=2)
        vb = lax.dynamic_slice_in_dim(v, r_start, kh, axis=2)
        k_win = kb[:, :, :, cidx]
        v_win = vb[:, :, :, cidx]
        q_row = lax.dynamic_index_in_dim(qs, r, axis=2, keepdims=False)
        dr = r_start + jnp.arange(kh) - r + (NA_WIN_H - 1)
        bias = rpb[:, dr[None, :, None], dc[:, None, :]]
        s_loc = jnp.einsum('bhqd,bhiqjd->bhqij', q_row, k_win) + bias[None]
        s_loc = s_loc.reshape(b, h, w, kh * kw)
        s_ctx = jnp.einsum('bhqd,bhcd->bhqc', q_row, kc)
        p = jax.nn.softmax(jnp.concatenate([s_loc, s_ctx], axis=-1).astype(jnp.float32), axis=-1).astype(v.dtype)
        p_loc = p[..., :kh * kw].reshape(b, h, w, kh, kw)
        p_ctx = p[..., kh * kw:]
        return (jnp.einsum('bhqij,bhiqjd->bhqd', p_loc, v_win)
                + jnp.einsum('bhqc,bhcd->bhqd', p_ctx, vc))

    out = lax.map(row_block, jnp.arange(n_rows))
    return out.transpose(1, 2, 0, 3, 4)


def _na_context(qc, kc, vc):
    s = jnp.einsum('bhqd,bhkd->bhqk', qc * (qc.shape[-1] ** -0.5), kc)
    p = jax.nn.softmax(s.astype(jnp.float32), axis=-1).astype(vc.dtype)
    return jnp.einsum('bhqk,bhkd->bhqd', p, vc)


def _ret_scan(q, k, v, log_g, s0, strict):
    b, h, n, dk = q.shape
    dv = v.shape[-1]
    L = RET_CHUNK
    nc = n // L
    lg = log_g.astype(jnp.float32)
    pos = jnp.arange(L, dtype=jnp.float32)
    diff = pos[:, None] - pos[None, :]
    keep = (diff > 0) if strict else (diff >= 0)
    dmat = jnp.where(keep[None], jnp.exp(lg[:, None, None] * jnp.maximum(diff, 0.0)[None]), 0.0).astype(q.dtype)
    xi = jnp.exp(lg[:, None] * (pos + 1.0)[None]).astype(q.dtype)[None, :, :, None]
    zeta = jnp.exp(lg[:, None] * (L - 1.0 - pos)[None]).astype(q.dtype)[None, :, :, None]
    g_chunk = jnp.exp(lg * L).astype(q.dtype)[None, :, None, None]

    def to_chunks(t):
        return t.reshape(b, h, nc, L, t.shape[-1]).transpose(2, 0, 1, 3, 4)

    def step(state, qkv):
        qc, kc, vc = qkv
        scores = jnp.einsum('bhld,bhmd->bhlm', qc, kc) * dmat
        out = (jnp.einsum('bhlm,bhmv->bhlv', scores, vc)
               + jnp.einsum('bhld,bhdv->bhlv', qc, state) * xi)
        state = g_chunk * state + jnp.einsum('bhmd,bhmv->bhdv', kc * zeta, vc)
        return state, out

    s_fin, outs = lax.scan(step, s0, (to_chunks(q), to_chunks(k), to_chunks(v)))
    return outs.transpose(1, 2, 0, 3, 4).reshape(b, h, n, dv), s_fin


def _bi_retention(q, k, v, lg_f, lg_b, s_f, s_b):
    o_f, sf = _ret_scan(q, k, v, lg_f, s_f, False)
    o_b, sb = _ret_scan(jnp.flip(q, 2), jnp.flip(k, 2), jnp.flip(v, 2), lg_b, s_b, True)
    return o_f + jnp.flip(o_b, 2), sf, sb


def _ret_output(o, g):
    of = o.astype(jnp.float32)
    mu = jnp.mean(of, axis=-1, keepdims=True)
    var = jnp.mean(jnp.square(of - mu), axis=-1, keepdims=True)
    on = ((of - mu) * lax.rsqrt(var + EPS)).astype(o.dtype)
    return _merge_heads(on) * jax.nn.silu(g)


def _merge(o_na, o_ret, gate_na, gate_ret, w_proj_na, w_proj_ret, w_out):
    merged = jax.nn.sigmoid(gate_na) * (o_na @ w_proj_na) + jax.nn.sigmoid(gate_ret) * (o_ret @ w_proj_ret)
    return merged @ w_out


def _conv_ffn(h, w_up, conv_w, conv_b, w_down):
    u = h @ w_up
    n = u.shape[1]
    pad = CONV_W // 2
    up = jnp.pad(u, ((0, 0), (pad, pad), (0, 0)))
    u = sum(up[:, i:i + n] * conv_w[i] for i in range(CONV_W)) + conv_b
    a, val = jnp.split(u, 2, axis=-1)
    return (jax.nn.silu(a) * val) @ w_down


def setup_inputs(seed: int = 0) -> dict:
    key = jax.random.key(seed)
    ks = jax.random.split(key, 20)

    def nrm(k, shape, s):
        return jax.random.normal(k, shape, jnp.float32) * s

    base_decay = jnp.asarray(np.log(1.0 - 2.0 ** (-5.0 - np.arange(RET_HEADS))), jnp.float32)
    return {
        "x": nrm(ks[0], (BATCH, SEQ, D_MODEL), 1.0),
        "c": nrm(ks[1], (BATCH, D_MODEL), 1.0),
        "ctx": nrm(ks[2], (BATCH, CTX_LEN, D_MODEL), 1.0),
        "c_ctx": nrm(ks[3], (D_MODEL,), 1.0),
        "w_ada": nrm(ks[4], (DEPTH, D_MODEL, 6 * D_MODEL), 0.5 * D_MODEL ** -0.5),
        "b_ada": nrm(ks[5], (DEPTH, 6 * D_MODEL), 0.01),
        "norm1_g": 1.0 + nrm(ks[6], (DEPTH, D_MODEL), 0.01),
        "w_in": nrm(ks[7], (DEPTH, D_MODEL, IN_COLS), D_MODEL ** -0.5),
        "na_rpb": nrm(ks[8], (DEPTH, NA_HEADS, 2 * NA_WIN_H - 1, 2 * NA_WIN_W - 1), 0.1),
        "ret_log_decay_fwd": base_decay[None] * (1.0 + nrm(ks[9], (DEPTH, RET_HEADS), 0.05)),
        "ret_log_decay_bwd": base_decay[None] * (1.0 + nrm(ks[10], (DEPTH, RET_HEADS), 0.05)),
        "w_proj_na": nrm(ks[11], (DEPTH, NA_W, D_MODEL), NA_W ** -0.5),
        "w_proj_ret": nrm(ks[12], (DEPTH, RET_V_W, D_MODEL), RET_V_W ** -0.5),
        "w_out": nrm(ks[13], (DEPTH, D_MODEL, D_MODEL), D_MODEL ** -0.5),
        "norm2_g": 1.0 + nrm(ks[14], (DEPTH, D_MODEL), 0.01),
        "w_up": nrm(ks[15], (DEPTH, D_MODEL, 2 * D_FF), D_MODEL ** -0.5),
        "conv_w": nrm(ks[16], (DEPTH, CONV_W, 2 * D_FF), CONV_W ** -0.5),
        "conv_b": nrm(ks[17], (DEPTH, 2 * D_FF), 0.01),
        "w_down": nrm(ks[18], (DEPTH, D_FF, D_MODEL), D_FF ** -0.5),
        "final_norm_g": 1.0 + nrm(ks[19], (D_MODEL,), 0.01),
    }


def reference(x, c, ctx, c_ctx, w_ada, b_ada, norm1_g, w_in, na_rpb, ret_log_decay_fwd,
              ret_log_decay_bwd, w_proj_na, w_proj_ret, w_out, norm2_g, w_up, conv_w, conv_b,
              w_down, final_norm_g):
    b, n, _ = x.shape
    n_rows = n // GRID_W
    t = jnp.arange(n)
    rows = t // GRID_W
    cols = t % GRID_W
    c_silu = jax.nn.silu(c)[:, None, :]
    cctx_silu = jax.nn.silu(c_ctx)[None, :]

    for l in range(DEPTH):
        last = l == DEPTH - 1
        sh1, sc1, g1, sh2, sc2, g2 = jnp.split(c_silu @ w_ada[l] + b_ada[l], 6, axis=-1)
        csh1, csc1, cg1, csh2, csc2, cg2 = jnp.split(cctx_silu @ w_ada[l] + b_ada[l], 6, axis=-1)

        hx = _modulate(_rmsnorm(x, norm1_g[l]), sh1, sc1)
        hc = _modulate(_rmsnorm(ctx, norm1_g[l]), csh1, csc1)
        (xq, xk, xv, xrq, xrk, xrv, xrg, xga, xgb) = jnp.split(hx @ w_in[l], IN_OFFSETS, axis=-1)
        (cq, ck, cv, crq, crk, crv, crg, cga, cgb) = jnp.split(hc @ w_in[l], IN_OFFSETS, axis=-1)

        kc_na, vc_na = _heads(ck, NA_HEADS), _heads(cv, NA_HEADS)
        grid = lambda tt: _heads(tt, NA_HEADS).reshape(b, NA_HEADS, n_rows, GRID_W, NA_HEAD_DIM)
        o_na = _na_latent(grid(xq), grid(xk), grid(xv), kc_na, vc_na, na_rpb[l])
        o_na = _merge_heads(o_na.reshape(b, NA_HEADS, n, NA_HEAD_DIM))

        rk_scale = RET_QK_DIM ** -0.5
        qc_r, kc_r, vc_r = _heads(crq, RET_HEADS), _heads(crk, RET_HEADS) * rk_scale, _heads(crv, RET_HEADS)
        s_zero = jnp.zeros((b, RET_HEADS, RET_QK_DIM, RET_V_DIM), x.dtype)
        o_ret_c, s_f, s_b = _bi_retention(qc_r, kc_r, vc_r, ret_log_decay_fwd[l], ret_log_decay_bwd[l], s_zero, s_zero)
        q_r = _rope2d(_heads(xrq, RET_HEADS), rows, cols)
        k_r = _rope2d(_heads(xrk, RET_HEADS), rows, cols) * rk_scale
        o_ret_x, _, _ = _bi_retention(q_r, k_r, _heads(xrv, RET_HEADS), ret_log_decay_fwd[l], ret_log_decay_bwd[l], s_f, s_b)
        o_ret = _ret_output(o_ret_x, xrg)

        x = x + g1 * _merge(o_na, o_ret, xga, xgb, w_proj_na[l], w_proj_ret[l], w_out[l])
        hx2 = _modulate(_rmsnorm(x, norm2_g[l]), sh2, sc2)
        x = x + g2 * _conv_ffn(hx2, w_up[l], conv_w[l], conv_b[l], w_down[l])

        if not last:
            o_na_c = _merge_heads(_na_context(_heads(cq, NA_HEADS), kc_na, vc_na))
            o_ret_c = _ret_output(o_ret_c, crg)
            ctx = ctx + cg1 * _merge(o_na_c, o_ret_c, cga, cgb, w_proj_na[l], w_proj_ret[l], w_out[l])
            hc2 = _modulate(_rmsnorm(ctx, norm2_g[l]), csh2, csc2)
            ctx = ctx + cg2 * _conv_ffn(hc2, w_up[l], conv_w[l], conv_b[l], w_down[l])

    return _rmsnorm(x, final_norm_g)
```

```cpp
#include <hip/hip_runtime.h>
#include <hip/hip_cooperative_groups.h>
#include <cstdio>
namespace cg = cooperative_groups;

typedef unsigned short u16;
typedef __attribute__((ext_vector_type(8))) short bf16x8;
typedef __attribute__((ext_vector_type(4))) short bf16x4;
typedef __attribute__((ext_vector_type(4))) float f32x4;
typedef __attribute__((ext_vector_type(4))) unsigned int u32x4;
typedef __attribute__((ext_vector_type(2))) unsigned int u32x2;

constexpr int T = 32768, TC = 2048;
constexpr long SEG = 33554432L;

constexpr long OFF_WIN = 0;
constexpr long OFF_WPNA = 13631488L;
constexpr long OFF_WPRET = 14680064L;
constexpr long OFF_WOUT = 16777216L;
constexpr long OFF_WUP = 18874368L;
constexpr long OFF_WDOWN = 30408704L;
constexpr long OFF_MOD = 36175872L;
constexpr long OFF_ROPE = 36397056L;
constexpr long OFF_HX = 37748736L;
constexpr long OFF_Y = 109051904L;
constexpr long OFF_NAQ = OFF_Y;
constexpr long OFF_NAK = OFF_Y + SEG;
constexpr long OFF_NAVT = OFF_Y + 2 * SEG;
constexpr long OFF_RQ = OFF_Y + 3 * SEG;
constexpr long OFF_RK = OFF_Y + 4 * SEG;
constexpr long OFF_KTF = OFF_Y + 5 * SEG;
constexpr long OFF_KTB = OFF_Y + 6 * SEG;
constexpr long OFF_RVT = OFF_Y + 7 * SEG;
constexpr long OFF_RG = OFF_Y + 9 * SEG;
constexpr long OFF_CNAK = OFF_Y + 11 * SEG;
constexpr long OFF_CNAVT = OFF_CNAK + 2097152L;
constexpr long OFF_CKTF = OFF_CNAVT + 2097152L;
constexpr long OFF_CKTB = OFF_CKTF + 2097152L;
constexpr long OFF_CRVT = OFF_CKTB + 2097152L;
constexpr long WS_END = OFF_CRVT + 4194304L;
constexpr long OFF_MERGED = OFF_RVT;
constexpr long OFF_ORAW = OFF_KTF;
constexpr long OFF_PARK2 = OFF_RQ;
constexpr long OFF_HACTF = OFF_HX + (long)T * 2048;
constexpr long OFF_UH = OFF_HACTF + (long)T * 2816 * 2;
constexpr long OFF_HACT = OFF_HACTF;
static_assert(OFF_UH + (long)T * 3072 * 2 <= WS_END, "FFN scratch must fit the workspace map");

constexpr int HALF_LDS = 73728;
constexpr int PARAM_OFF = 2 * HALF_LDS;
constexpr int LDS_BYTES = PARAM_OFF + 256;

struct Params {
  const float *x, *c, *ctx, *c_ctx, *w_ada, *b_ada, *norm1_g, *w_in, *na_rpb, *ldf, *ldb, *w_pna, *w_pret, *w_out,
      *norm2_g, *w_up, *conv_w, *conv_b, *w_down, *final_g;
  float* out;
  char* ws;
};

typedef float f32x2_t __attribute__((ext_vector_type(2)));
typedef __bf16 bf16x2_t __attribute__((ext_vector_type(2)));
__device__ __forceinline__ unsigned pack2(float a, float b) {
  f32x2_t v = {a, b};
  bf16x2_t r = __builtin_convertvector(v, bf16x2_t);
  return __builtin_bit_cast(unsigned, r);
}
__device__ __forceinline__ u16 f2bf(float f) { return (u16)(pack2(f, 0.f) & 0xffffu); }
__device__ __forceinline__ float bf2f(u16 h) { return __uint_as_float(((unsigned)h) << 16); }
__device__ __forceinline__ u32x2 pack4(float a, float b, float c, float d) {
  u32x2 r = {pack2(a, b), pack2(c, d)}; return r;
}
__device__ __forceinline__ float sigmoidf_(float x) { return __builtin_amdgcn_rcpf(1.f + __expf(-x)); }
__device__ __forceinline__ float siluf_(float x) { return x * __builtin_amdgcn_rcpf(1.f + __expf(-x)); }

#define MFMA(a, b, c) __builtin_amdgcn_mfma_f32_16x16x32_bf16((a), (b), (c), 0, 0, 0)

__device__ __forceinline__ int lds_byte2(int r, int c) {
  int st = (r >> 4) * 2 + (c >> 5), ob = (r & 15) * 64 + (c & 31) * 2;
  return st * 1024 + (ob ^ (((ob >> 9) & 1) << 5));
}
__device__ __forceinline__ void stage_rc2(int b, int& R, int& C) {
  int st = b >> 10, sb = b & 1023, swz = sb ^ (((sb >> 9) & 1) << 5);
  R = (st >> 1) * 16 + swz / 64;
  C = (st & 1) * 32 + (swz % 64) / 2;
}
struct GA { const u16* A; const u16* B; int lda, ldb; };
template <bool SWAP>
__device__ __forceinline__ void gemm256(f32x4 (&acc)[8][4], const u16* __restrict__ A, long lda,
                                        const u16* __restrict__ B, long ldb, int K, char* shm, bool pre, GA nx) {
  constexpr int TILE_B = 256 * 64 * 2, STAGE_B = 2 * TILE_B;
  int tid = threadIdx.x;
  asm volatile("" : "+v"(tid));
  const int wid = tid >> 6, lane = tid & 63, wr = wid >> 2, wc = wid & 3, fr = lane & 15, fq = lane >> 4;
  unsigned offA[4], offB[4];
#pragma unroll
  for (int i = 0; i < 4; ++i) {
    int R, C;
    stage_rc2(wid * 1024 + i * 8192 + lane * 16, R, C);
    offA[i] = (unsigned)(R * (int)lda + C);
    offB[i] = (unsigned)(R * (int)ldb + C);
  }
#define G256_STAGE(buf, kt)                                                                                         \
  do {                                                                                                              \
    _Pragma("unroll") for (int i = 0; i < 4; ++i) {                                                                 \
      __builtin_amdgcn_global_load_lds((const unsigned*)(A + offA[i] + (kt) * 64),                                  \
                                       (__attribute__((address_space(3))) unsigned*)(shm + (buf) * STAGE_B + wid * 1024 + i * 8192), 16, 0, 0); \
      __builtin_amdgcn_global_load_lds((const unsigned*)(B + offB[i] + (kt) * 64),                                  \
                                       (__attribute__((address_space(3))) unsigned*)(shm + (buf) * STAGE_B + TILE_B + wid * 1024 + i * 8192), 16, 0, 0); \
    }                                                                                                               \
  } while (0)
  const int nt = K >> 6;
  if (!pre) G256_STAGE(0, 0);
  asm volatile("s_waitcnt vmcnt(0)" ::: "memory");
  __syncthreads();
  for (int t = 0; t < nt; ++t) {
    const int cur = t & 1;
    if (t + 1 < nt) G256_STAGE(cur ^ 1, t + 1);
    const char* sa = shm + cur * STAGE_B;
    const char* sb = sa + TILE_B;
#pragma unroll
    for (int ks = 0; ks < 2; ++ks) {
      bf16x8 Bf[4];
#pragma unroll
      for (int n = 0; n < 4; ++n) Bf[n] = *(const bf16x8*)(sb + lds_byte2(wc * 64 + n * 16 + fr, ks * 32 + fq * 8));
#pragma unroll
      for (int mh = 0; mh < 2; ++mh) {
        bf16x8 At[4];
#pragma unroll
        for (int m = 0; m < 4; ++m) At[m] = *(const bf16x8*)(sa + lds_byte2(wr * 128 + (mh * 4 + m) * 16 + fr, ks * 32 + fq * 8));
#pragma unroll
        for (int m = 0; m < 4; ++m)
#pragma unroll
          for (int n = 0; n < 4; ++n) {
            if (SWAP) acc[mh * 4 + m][n] = MFMA(Bf[n], At[m], acc[mh * 4 + m][n]);
            else acc[mh * 4 + m][n] = MFMA(At[m], Bf[n], acc[mh * 4 + m][n]);
          }
      }
      __builtin_amdgcn_sched_group_barrier(0x100, 8, 0);
      __builtin_amdgcn_sched_group_barrier(0x008, 4, 0);
      __builtin_amdgcn_sched_group_barrier(0x100, 1, 0);
      __builtin_amdgcn_sched_group_barrier(0x008, 4, 0);
      __builtin_amdgcn_sched_group_barrier(0x100, 1, 0);
      __builtin_amdgcn_sched_group_barrier(0x008, 4, 0);
      __builtin_amdgcn_sched_group_barrier(0x100, 1, 0);
      __builtin_amdgcn_sched_group_barrier(0x008, 4, 0);
      __builtin_amdgcn_sched_group_barrier(0x100, 1, 0);
      __builtin_amdgcn_sched_group_barrier(0x008, 16, 0);
      __builtin_amdgcn_sched_barrier(0);
    }
    asm volatile("s_waitcnt vmcnt(0)" ::: "memory");
    __syncthreads();
  }
#undef G256_STAGE
  if (nx.A != nullptr) {
#pragma unroll
    for (int i = 0; i < 4; ++i) {
      int R, C;
      stage_rc2(wid * 1024 + i * 8192 + lane * 16, R, C);
      __builtin_amdgcn_global_load_lds((const unsigned*)(nx.A + (unsigned)(R * nx.lda + C)),
                                       (__attribute__((address_space(3))) unsigned*)(shm + wid * 1024 + i * 8192), 16, 0, 0);
      __builtin_amdgcn_global_load_lds((const unsigned*)(nx.B + (unsigned)(R * nx.ldb + C)),
                                       (__attribute__((address_space(3))) unsigned*)(shm + TILE_B + wid * 1024 + i * 8192), 16, 0, 0);
    }
  }
}

__device__ __forceinline__ void zero_acc(f32x4 (&acc)[8][4]) {
#pragma unroll
  for (int i = 0; i < 8; ++i)
#pragma unroll
    for (int j = 0; j < 4; ++j) acc[i][j] = f32x4{0.f, 0.f, 0.f, 0.f};
}

#define EPI_IDS int tid = threadIdx.x; asm volatile("" : "+v"(tid)); const int wid = tid >> 6, lane = tid & 63, wr = wid >> 2, wc = wid & 3, fr = lane & 15, fq = lane >> 4
__device__ __forceinline__ void tile_mn(int id, int NT, int& mt, int& nt) {
  const int G = 16;
  int grp = id / (G * NT), rem = id % (G * NT);
  nt = rem / G;
  mt = grp * G + (rem % G);
}

__device__ __forceinline__ void p0_transpose(const float* __restrict__ src, int K, int N, u16* __restrict__ dst, int tile, float* lds, int tid) {
  const int nk = K >> 6;
  const int tk = tile % nk, tn = tile / nk;
  const int k0 = tk * 64, n0 = tn * 64;
  {
    const int r0 = tid >> 4, c = (tid & 15) * 4;
    float4 v0 = *(const float4*)(src + (long)(k0 + r0) * N + n0 + c);
    float4 v1 = *(const float4*)(src + (long)(k0 + r0 + 16) * N + n0 + c);
    float4 v2 = *(const float4*)(src + (long)(k0 + r0 + 32) * N + n0 + c);
    float4 v3 = *(const float4*)(src + (long)(k0 + r0 + 48) * N + n0 + c);
    float* l0 = lds + r0 * 65 + c;
    l0[0] = v0.x; l0[1] = v0.y; l0[2] = v0.z; l0[3] = v0.w;
    l0[16 * 65 + 0] = v1.x; l0[16 * 65 + 1] = v1.y; l0[16 * 65 + 2] = v1.z; l0[16 * 65 + 3] = v1.w;
    l0[32 * 65 + 0] = v2.x; l0[32 * 65 + 1] = v2.y; l0[32 * 65 + 2] = v2.z; l0[32 * 65 + 3] = v2.w;
    l0[48 * 65 + 0] = v3.x; l0[48 * 65 + 1] = v3.y; l0[48 * 65 + 2] = v3.z; l0[48 * 65 + 3] = v3.w;
  }
  __syncthreads();
#pragma unroll 4
  for (int i = 0; i < 8; ++i) {
    int idx = tid + i * 256;
    int n = idx >> 5, kp = idx & 31;
    unsigned v = pack2(lds[(2 * kp) * 65 + n], lds[(2 * kp + 1) * 65 + n]);
    *(unsigned*)(dst + (long)(n0 + n) * K + k0 + 2 * kp) = v;
  }
  __syncthreads();
}

__device__ __forceinline__ void p0_adaln(const Params& p, int u, float* sl, int tid) {
  const int col0 = u * 32;
  for (int i = tid; i < 9 * 1024; i += 256) {
    int r = i >> 10, k = i & 1023;
    float v = (r < 8) ? p.c[r * 1024 + k] : p.c_ctx[k];
    sl[i] = v / (1.f + expf(-v));
  }
  __syncthreads();
  const int col = tid & 31, kg = tid >> 5;
  float acc[9];
#pragma unroll
  for (int r = 0; r < 9; ++r) acc[r] = 0.f;
#pragma unroll 4
  for (int k = kg * 128; k < kg * 128 + 128; ++k) {
    float wv = p.w_ada[(long)k * 6144 + col0 + col];
#pragma unroll
    for (int r = 0; r < 9; ++r) acc[r] += sl[r * 1024 + k] * wv;
  }
  float* red = sl + 9216;
#pragma unroll
  for (int r = 0; r < 9; ++r) red[(kg * 9 + r) * 32 + col] = acc[r];
  __syncthreads();
  for (int i = tid; i < 288; i += 256) {
    int r = i >> 5, cc = i & 31;
    float s = 0.f;
#pragma unroll
    for (int k2 = 0; k2 < 8; ++k2) s += red[(k2 * 9 + r) * 32 + cc];
    float* mod = (float*)(p.ws + OFF_MOD);
    mod[r * 6144 + col0 + cc] = s + p.b_ada[col0 + cc];
  }
  __syncthreads();
}

__device__ __forceinline__ void my_sincos(double x, double* s, double* c) {
  double kd = rint(x * 0.63661977236758134308);
  int k = (int)kd;
  double r = x - kd * 1.5707963267948966192;
  r -= kd * 6.123233995736766e-17;
  double r2 = r * r;
  double sp = r * (1.0 + r2 * (-1.0 / 6.0 + r2 * (1.0 / 120.0 + r2 * (-1.0 / 5040.0 + r2 * (1.0 / 362880.0 + r2 * (-1.0 / 39916800.0 + r2 * (1.0 / 6227020800.0 + r2 * (-1.0 / 1307674368000.0))))))));
  double cp = 1.0 + r2 * (-0.5 + r2 * (1.0 / 24.0 + r2 * (-1.0 / 720.0 + r2 * (1.0 / 40320.0 + r2 * (-1.0 / 3628800.0 + r2 * (1.0 / 479001600.0 + r2 * (-1.0 / 87178291200.0 + r2 * (1.0 / 20922789888000.0))))))));
  int q = k & 3;
  if (q == 0) { *s = sp; *c = cp; }
  else if (q == 1) { *s = cp; *c = -sp; }
  else if (q == 2) { *s = -sp; *c = -cp; }
  else { *s = -cp; *c = sp; }
}

__device__ __forceinline__ void p0_rope(const Params& p, int tid) {
  float* tab = (float*)(p.ws + OFF_ROPE);
  for (int e = tid * 8; e < tid * 8 + 8; ++e) {
    int pos = e >> 5, i = e & 31;
    double inv = exp(-(double)i * (9.210340371976184 / 32.0));
    float invf = (float)inv;
    float ang = (float)pos * invf;
    double s, c;
    my_sincos((double)ang, &s, &c);
    tab[e * 2] = (float)c;
    tab[e * 2 + 1] = (float)s;
  }
}

__device__ __forceinline__ void p0_unit(const Params& p, int u, char* smem, int tid) {
  float* lds = (float*)smem;
  if (u < 1664) { p0_transpose(p.w_in, 1024, 6656, (u16*)(p.ws + OFF_WIN), u, lds, tid); return; }
  u -= 1664;
  if (u < 128) { p0_transpose(p.w_pna, 512, 1024, (u16*)(p.ws + OFF_WPNA), u, lds, tid); return; }
  u -= 128;
  if (u < 256) { p0_transpose(p.w_pret, 1024, 1024, (u16*)(p.ws + OFF_WPRET), u, lds, tid); return; }
  u -= 256;
  if (u < 256) { p0_transpose(p.w_out, 1024, 1024, (u16*)(p.ws + OFF_WOUT), u, lds, tid); return; }
  u -= 256;
  if (u < 1408) { p0_transpose(p.w_up, 1024, 5632, (u16*)(p.ws + OFF_WUP), u, lds, tid); return; }
  u -= 1408;
  if (u < 704) { p0_transpose(p.w_down, 2816, 1024, (u16*)(p.ws + OFF_WDOWN), u, lds, tid); return; }
  u -= 704;
  if (u < 192) { p0_adaln(p, u, lds, tid); return; }
  p0_rope(p, tid);
}
constexpr int P0_UNITS = 1664 + 128 + 256 + 256 + 1408 + 704 + 192 + 1;

__device__ __forceinline__ float wave_sum(float v) {
#pragma unroll
  for (int o = 32; o >= 1; o >>= 1) v += __shfl_xor(v, o);
  return v;
}

__device__ __forceinline__ void rownorm2_bf16(const float* __restrict__ src, const float* __restrict__ gain,
                                              const float* __restrict__ shift, const float* __restrict__ scale,
                                              u16* __restrict__ dst) {
  const int lane = threadIdx.x & 63;
  float4 v[2][4];
#pragma unroll
  for (int r = 0; r < 2; ++r)
#pragma unroll
    for (int i = 0; i < 4; ++i) {
      const f32x4 t4 = __builtin_nontemporal_load((const f32x4*)(src + r * 1024) + lane + i * 64);
      v[r][i].x = t4[0]; v[r][i].y = t4[1]; v[r][i].z = t4[2]; v[r][i].w = t4[3];
    }
  float ss0 = 0.f, ss1 = 0.f;
#pragma unroll
  for (int i = 0; i < 4; ++i) {
    ss0 += v[0][i].x * v[0][i].x + v[0][i].y * v[0][i].y + v[0][i].z * v[0][i].z + v[0][i].w * v[0][i].w;
    ss1 += v[1][i].x * v[1][i].x + v[1][i].y * v[1][i].y + v[1][i].z * v[1][i].z + v[1][i].w * v[1][i].w;
  }
  ss0 = wave_sum(ss0);
  ss1 = wave_sum(ss1);
  const float r0 = rsqrtf(ss0 * (1.f / 1024.f) + 1e-6f), r1 = rsqrtf(ss1 * (1.f / 1024.f) + 1e-6f);
#pragma unroll
  for (int i = 0; i < 4; ++i) {
    const int c4 = lane + i * 64;
    float4 gn = ((const float4*)gain)[c4];
    float4 sh = ((const float4*)shift)[c4];
    float4 sc = ((const float4*)scale)[c4];
    *(u32x2*)(dst + c4 * 4) = pack4((v[0][i].x * r0 * gn.x) * (1.f + sc.x) + sh.x, (v[0][i].y * r0 * gn.y) * (1.f + sc.y) + sh.y,
                                    (v[0][i].z * r0 * gn.z) * (1.f + sc.z) + sh.z, (v[0][i].w * r0 * gn.w) * (1.f + sc.w) + sh.w);
    *(u32x2*)(dst + 1024 + c4 * 4) = pack4((v[1][i].x * r1 * gn.x) * (1.f + sc.x) + sh.x, (v[1][i].y * r1 * gn.y) * (1.f + sc.y) + sh.y,
                                           (v[1][i].z * r1 * gn.z) * (1.f + sc.z) + sh.z, (v[1][i].w * r1 * gn.w) * (1.f + sc.w) + sh.w);
  }
}


constexpr int WST_OFF = 65536;
constexpr int WST_BYTES = 9216;
constexpr int ZTAB_OFF = WST_OFF + 8 * WST_BYTES;

__device__ __forceinline__ void wave_store_nat_bf16(const f32x4 (&acc)[8][4], char* smem, u16* dst, long ld, float mul,
                                                    int wid, int lane, int fr, int fq) {
  u16* st = (u16*)(smem + WST_OFF + wid * WST_BYTES);
#pragma unroll
  for (int ps = 0; ps < 2; ++ps) {
#pragma unroll
    for (int m4 = 0; m4 < 4; ++m4)
#pragma unroll
      for (int n = 0; n < 4; ++n)
        *(u32x2*)(st + (m4 * 16 + fr) * 72 + n * 16 + fq * 4) =
            pack4(acc[ps * 4 + m4][n][0] * mul, acc[ps * 4 + m4][n][1] * mul, acc[ps * 4 + m4][n][2] * mul, acc[ps * 4 + m4][n][3] * mul);
#pragma unroll
    for (int i = 0; i < 8; ++i) {
      int id = lane + i * 64;
      int rl = id >> 3, c8 = (id & 7) * 8;
      __builtin_nontemporal_store(*(const u32x4*)(st + rl * 72 + c8), (u32x4*)(dst + (long)(ps * 64 + rl) * ld + c8));
    }
  }
}
__device__ __forceinline__ void wave_stage_tr(const f32x4 (&acc)[8][4], u16* st, int ps, float mul, int fr, int fq) {
#pragma unroll
  for (int nl = 0; nl < 2; ++nl)
#pragma unroll
    for (int m = 0; m < 8; ++m)
      *(u32x2*)(st + (nl * 16 + fr) * 136 + m * 16 + fq * 4) =
          pack4(acc[m][ps * 2 + nl][0] * mul, acc[m][ps * 2 + nl][1] * mul, acc[m][ps * 2 + nl][2] * mul, acc[m][ps * 2 + nl][3] * mul);
}
__device__ __forceinline__ void wave_store_tr_bf16(const f32x4 (&acc)[8][4], char* smem, u16* dstT, long tstride,
                                                   int wid, int lane, int fr, int fq) {
  u16* st = (u16*)(smem + WST_OFF + wid * WST_BYTES);
#pragma unroll
  for (int ps = 0; ps < 2; ++ps) {
    wave_stage_tr(acc, st, ps, 1.f, fr, fq);
#pragma unroll
    for (int i = 0; i < 8; ++i) {
      int id = lane + i * 64;
      int cl = id >> 4, r8 = (id & 15) * 8;
      __builtin_nontemporal_store(*(const u32x4*)(st + cl * 136 + r8), (u32x4*)(dstT + (long)(ps * 32 + cl) * tstride + r8));
    }
  }
}

template <int KIND>
__device__ __forceinline__ void inproj_kind(const Params& p, bool isctx, int m0, int nt256, char* smem, bool pre, GA nx) {
  const u16* A = (const u16*)(p.ws + OFF_HX) + (long)((isctx ? T : 0) + m0) * 1024;
  const u16* Bt = (const u16*)(p.ws + OFF_WIN) + (long)nt256 * 256 * 1024;
  const int seg = nt256 >> 1;
  const float2* rope = (const float2*)(p.ws + OFF_ROPE);
  f32x4 acc[8][4];
  zero_acc(acc);
  if (KIND == 0 || KIND == 1) {
    gemm256<true>(acc, A, 1024, Bt, 1024, 1024, smem, pre, nx);
    EPI_IDS;
    if (KIND == 1) {
#pragma unroll
      for (int m = 0; m < 8; ++m) {
        int n_ = (m0 + wr * 128 + m * 16 + fr) & 4095;
        int pos = ((wc & 1) == 0) ? (n_ >> 6) : (n_ & 63);
        const float2* rp = rope + pos * 32 + fq * 4;
#pragma unroll
        for (int nt = 0; nt < 2; ++nt) {
          float4 c01 = *(const float4*)(rp + nt * 16);
          float4 c23 = *(const float4*)(rp + nt * 16 + 2);
          float cs_[4] = {c01.x, c01.z, c23.x, c23.z}, sn_[4] = {c01.y, c01.w, c23.y, c23.w};
#pragma unroll
          for (int j = 0; j < 4; ++j) {
            float lo = acc[m][nt][j], hi = acc[m][nt + 2][j];
            acc[m][nt][j] = lo * cs_[j] - hi * sn_[j];
            acc[m][nt + 2][j] = lo * sn_[j] + hi * cs_[j];
          }
        }
      }
    }
    u16* dst; int ld; int cbase; float mul = 1.f;
    if (KIND == 1) { dst = (u16*)(p.ws + OFF_RQ); ld = 512; cbase = nt256 * 256 - 1536; }
    else if (seg == 0) { dst = (u16*)(p.ws + OFF_NAQ); ld = 512; cbase = nt256 * 256; mul = 0.125f; }
    else if (seg == 1) { dst = isctx ? (u16*)(p.ws + OFF_CNAK) : (u16*)(p.ws + OFF_NAK); ld = 512; cbase = nt256 * 256 - 512; }
    else { dst = (u16*)(p.ws + OFF_RG); ld = 1024; cbase = nt256 * 256 - 3584; }
    wave_store_nat_bf16(acc, smem, dst + (long)(m0 + wr * 128) * ld + cbase + wc * 64, ld, mul, wid, lane, fr, fq);
  } else {
    if (KIND == 3) {
      float* ztw = (float*)(smem + ZTAB_OFF);
      const int t_ = threadIdx.x;
      __syncthreads();
      if (t_ < 256) {
        int hh = (nt256 & 1) * 2 + (t_ >> 7), mm = t_ & 127;
        ztw[t_] = expf(p.ldf[hh] * (float)(127 - mm));
        ztw[256 + t_] = expf(p.ldb[hh] * (float)mm);
      }
    }
    gemm256<false>(acc, A, 1024, Bt, 1024, 1024, smem, pre, nx);
    EPI_IDS;
    const int bb = isctx ? (m0 >> 8) : (m0 >> 12);
    const int nbase = isctx ? 0 : (m0 & 4095);
    const long tstride = isctx ? 256 : 4096;
    if (KIND == 2) {
      u16* dst; int cg0; long bstride;
      if (seg == 2) { dst = isctx ? (u16*)(p.ws + OFF_CNAVT) : (u16*)(p.ws + OFF_NAVT); cg0 = nt256 * 256 - 1024; bstride = 512; }
      else { dst = isctx ? (u16*)(p.ws + OFF_CRVT) : (u16*)(p.ws + OFF_RVT); cg0 = nt256 * 256 - 2560; bstride = 1024; }
      wave_store_tr_bf16(acc, smem, dst + ((long)bb * bstride + cg0 + wc * 64) * tstride + nbase + wr * 128, tstride, wid, lane, fr, fq);
    } else {
      const int h = (nt256 & 1) * 2 + (wc >> 1);
      const float rks = 0.08838834764831845f;
      const float* ztab = (const float*)(smem + ZTAB_OFF);
      if (!isctx) {
#pragma unroll
        for (int m = 0; m < 8; ++m) {
#pragma unroll
          for (int j = 0; j < 4; ++j) {
            int n_ = (m0 + wr * 128 + m * 16 + fq * 4 + j) & 4095;
            int pos = ((wc & 1) == 0) ? (n_ >> 6) : (n_ & 63);
#pragma unroll
            for (int nt = 0; nt < 2; ++nt) {
              float2 cs = rope[pos * 32 + nt * 16 + fr];
              float lo = acc[m][nt][j], hi = acc[m][nt + 2][j];
              acc[m][nt][j] = lo * cs.x - hi * cs.y;
              acc[m][nt + 2][j] = lo * cs.y + hi * cs.x;
            }
          }
        }
      }
      u16* rk = (u16*)(p.ws + OFF_RK);
      u16* ktf = isctx ? (u16*)(p.ws + OFF_CKTF) : (u16*)(p.ws + OFF_KTF);
      u16* ktb = isctx ? (u16*)(p.ws + OFF_CKTB) : (u16*)(p.ws + OFF_KTB);
      u16* st = (u16*)(smem + WST_OFF + wid * WST_BYTES);
      const float* zfh = ztab + (wc >> 1) * 128;
      const float* zbh = ztab + 256 + (wc >> 1) * 128;
      const int dkb = (wc & 1) * 64;
#pragma unroll
      for (int ps = 0; ps < 2; ++ps) {
        wave_stage_tr(acc, st, ps, rks, fr, fq);
#pragma unroll
        for (int i = 0; i < 8; ++i) {
          int id = lane + i * 64;
          int cl = id >> 4, r8 = (id & 15) * 8;
          u32x4 v = *(const u32x4*)(st + cl * 136 + r8);
          float4 zf0 = *(const float4*)(zfh + r8), zf1 = *(const float4*)(zfh + r8 + 4);
          float4 zb0 = *(const float4*)(zbh + r8), zb1 = *(const float4*)(zbh + r8 + 4);
          float e0 = bf2f((u16)(v[0] & 0xffffu)), e1 = bf2f((u16)(v[0] >> 16)), e2 = bf2f((u16)(v[1] & 0xffffu)), e3 = bf2f((u16)(v[1] >> 16));
          float e4 = bf2f((u16)(v[2] & 0xffffu)), e5 = bf2f((u16)(v[2] >> 16)), e6 = bf2f((u16)(v[3] & 0xffffu)), e7 = bf2f((u16)(v[3] >> 16));
          long tb = ((long)(bb * 4 + h) * 128 + dkb + ps * 32 + cl) * tstride + nbase + wr * 128 + r8;
          u32x4 of = {pack2(e0 * zf0.x, e1 * zf0.y), pack2(e2 * zf0.z, e3 * zf0.w), pack2(e4 * zf1.x, e5 * zf1.y), pack2(e6 * zf1.z, e7 * zf1.w)};
          u32x4 ob = {pack2(e0 * zb0.x, e1 * zb0.y), pack2(e2 * zb0.z, e3 * zb0.w), pack2(e4 * zb1.x, e5 * zb1.y), pack2(e6 * zb1.z, e7 * zb1.w)};
          *(u32x4*)(ktf + tb) = of;
          *(u32x4*)(ktb + tb) = ob;
        }
        if (!isctx) {
#pragma unroll
          for (int i = 0; i < 8; ++i) {
            int id = lane + i * 64;
            int row = id >> 2, c8 = (id & 3) * 8;
            const u16* sp = st + c8 * 136 + row;
            u32x4 o = {(unsigned)sp[0] | ((unsigned)sp[136] << 16), (unsigned)sp[2 * 136] | ((unsigned)sp[3 * 136] << 16),
                       (unsigned)sp[4 * 136] | ((unsigned)sp[5 * 136] << 16), (unsigned)sp[6 * 136] | ((unsigned)sp[7 * 136] << 16)};
            *(u32x4*)(rk + (long)(m0 + wr * 128 + row) * 512 + h * 128 + dkb + ps * 32 + c8) = o;
          }
        }
      }
    }
  }
}

__device__ __forceinline__ void inproj_decode(int id, bool& isctx, int& m0, int& nt256) {
  int mt_;
  if (id < 2304) { isctx = false; tile_mn(id, 18, mt_, nt256); }
  else {
    isctx = true;
    int id2 = id - 2304;
    mt_ = id2 & 7;
    int j = id2 >> 3;
    nt256 = (j < 4) ? (2 + j) : ((j < 6) ? (8 + (j - 4)) : (10 + (j - 6)));
  }
  m0 = mt_ * 256;
}
__device__ __forceinline__ GA inproj_ga(const Params& p, int id) {
  GA g; g.A = nullptr; g.B = nullptr; g.lda = 1024; g.ldb = 1024;
  if (id < 2304 + 80) {
    bool isctx; int m0, nt256;
    inproj_decode(id, isctx, m0, nt256);
    g.A = (const u16*)(p.ws + OFF_HX) + (long)((isctx ? T : 0) + m0) * 1024;
    g.B = (const u16*)(p.ws + OFF_WIN) + (long)nt256 * 256 * 1024;
  }
  return g;
}
__device__ __forceinline__ void inproj_tile(const Params& p, int id, char* smem, bool pre, GA nx) {
  bool isctx;
  int m0, nt256;
  inproj_decode(id, isctx, m0, nt256);
  const int seg = nt256 >> 1;
  if (seg == 3) inproj_kind<1>(p, isctx, m0, nt256, smem, pre, nx);
  else if (seg == 4) inproj_kind<3>(p, isctx, m0, nt256, smem, pre, nx);
  else if (seg == 2 || seg == 5 || seg == 6) inproj_kind<2>(p, isctx, m0, nt256, smem, pre, nx);
  else inproj_kind<0>(p, isctx, m0, nt256, smem, pre, nx);
}

struct NaRegs { u32x4 k0, k1, k2, k3, v0, v1, v2, v3, q0, q1; };

__device__ __forceinline__ void na_issue(const Params& p, int u, int chunk, int tid, NaRegs& R) {
  const int r = u & 63, head = (u >> 6) & 7, b = u >> 9;
  const int rs = min(max(r - 4, 0), 56);
  const int krow = tid >> 3, kcc = (tid & 7) * 8;
  const int vrow = tid >> 4, vcc = (tid & 15) * 8;
  const u16* kb; long ks_; const u16* vb; long vs_;
  if (chunk < 4) {
    kb = (const u16*)(p.ws + OFF_NAK) + (long)(b * 4096 + rs * 64 + chunk * 128 + krow) * 512 + head * 64 + kcc; ks_ = 32L * 512;
    vb = (const u16*)(p.ws + OFF_NAVT) + ((long)((b * 8 + head) * 64 + vrow)) * 4096 + rs * 64 + chunk * 128 + vcc; vs_ = 16L * 4096;
  } else {
    kb = (const u16*)(p.ws + OFF_CNAK) + (long)(b * 256 + (chunk - 4) * 128 + krow) * 512 + head * 64 + kcc; ks_ = 32L * 512;
    vb = (const u16*)(p.ws + OFF_CNAVT) + ((long)((b * 8 + head) * 64 + vrow)) * 256 + (chunk - 4) * 128 + vcc; vs_ = 16L * 256;
  }
  R.k0 = *(const u32x4*)(kb); R.k1 = *(const u32x4*)(kb + ks_); R.k2 = *(const u32x4*)(kb + 2 * ks_); R.k3 = *(const u32x4*)(kb + 3 * ks_);
  R.v0 = *(const u32x4*)(vb); R.v1 = *(const u32x4*)(vb + vs_); R.v2 = *(const u32x4*)(vb + 2 * vs_); R.v3 = *(const u32x4*)(vb + 3 * vs_);
  if (chunk == 0) {
    const u16* qb = (const u16*)(p.ws + OFF_NAQ) + (long)(b * 4096 + r * 64 + krow) * 512 + head * 64 + kcc;
    R.q0 = *(const u32x4*)(qb);
    R.q1 = *(const u32x4*)(qb + 32L * 512);
  }
}

__device__ __forceinline__ void na_run(const Params& p, int first, int stride, int count, char* smem, int tid) {
  u16* Qs = (u16*)smem;
  u16* Ks = Qs + 64 * 72;
  u16* Vt = Ks + 128 * 72;
  float* bias = (float*)(Vt + 64 * 136);
  const int lane = tid & 63, w = tid >> 6, l15 = lane & 15, g = lane >> 4;
  const int krow = tid >> 3, kcc = (tid & 7) * 8, vrow = tid >> 4, vcc = (tid & 15) * 8;
  const int qc = w * 16 + l15;
  const int cs = min(max(qc - 8, 0), 48);
  const int cw = min(max(16 * w - 8, 0), 32);
  int dco[2][4];
  unsigned okm = 0u;
#pragma unroll
  for (int tt = 0; tt < 2; ++tt)
#pragma unroll
    for (int j = 0; j < 4; ++j) {
      int kc = cw + tt * 16 + g * 4 + j;
      if ((kc >= cs) && (kc < cs + 16)) okm |= 1u << (tt * 4 + j);
      dco[tt][j] = min(max(kc - qc + 15, 0), 30);
    }
  NaRegs R;
  if (count > 0) na_issue(p, first, 0, tid, R);
  for (int k = 0; k < count; ++k) {
    const int u = first + k * stride;
    const int r = u & 63, head = (u >> 6) & 7, b = u >> 9;
    const int rs = min(max(r - 4, 0), 56);
    f32x4 O[4];
#pragma unroll
    for (int i = 0; i < 4; ++i) O[i] = f32x4{0.f, 0.f, 0.f, 0.f};
    float m_run = -1e30f, l_run = 0.f;
    bf16x8 qf[2];
    for (int chunk = 0; chunk < 6; ++chunk) {
      __syncthreads();
      *(u32x4*)(Ks + krow * 72 + kcc) = R.k0; *(u32x4*)(Ks + (krow + 32) * 72 + kcc) = R.k1;
      *(u32x4*)(Ks + (krow + 64) * 72 + kcc) = R.k2; *(u32x4*)(Ks + (krow + 96) * 72 + kcc) = R.k3;
      *(u32x4*)(Vt + vrow * 136 + vcc) = R.v0; *(u32x4*)(Vt + (vrow + 16) * 136 + vcc) = R.v1;
      *(u32x4*)(Vt + (vrow + 32) * 136 + vcc) = R.v2; *(u32x4*)(Vt + (vrow + 48) * 136 + vcc) = R.v3;
      if (chunk == 0) {
        *(u32x4*)(Qs + krow * 72 + kcc) = R.q0; *(u32x4*)(Qs + (krow + 32) * 72 + kcc) = R.q1;
        for (int i = tid; i < 465; i += 256) bias[i] = p.na_rpb[head * 465 + i];
      }
      __syncthreads();
      if (chunk < 5) na_issue(p, u, chunk + 1, tid, R);
      else if (k + 1 < count) na_issue(p, u + stride, 0, tid, R);
      if (chunk == 0) {
        qf[0] = *(const bf16x8*)(Qs + (w * 16 + l15) * 72 + g * 8);
        qf[1] = *(const bf16x8*)(Qs + (w * 16 + l15) * 72 + 32 + g * 8);
      }
#pragma unroll
      for (int kg = 0; kg < 4; ++kg) {
        if (chunk < 4 && kg >= 2) continue;
        const int kb = (chunk < 4) ? (kg * 64 + cw) : (kg * 32);
        const int boff = (rs - r + 7 + chunk * 2 + kg) * 31;
        f32x4 s[2];
#pragma unroll
        for (int tt = 0; tt < 2; ++tt) {
          s[tt] = f32x4{0.f, 0.f, 0.f, 0.f};
#pragma unroll
          for (int ks = 0; ks < 2; ++ks) {
            bf16x8 a = *(const bf16x8*)(Ks + (kb + tt * 16 + l15) * 72 + ks * 32 + g * 8);
            s[tt] = MFMA(a, qf[ks], s[tt]);
          }
        }
        float mx = -1e30f;
#pragma unroll
        for (int tt = 0; tt < 2; ++tt)
#pragma unroll
          for (int j = 0; j < 4; ++j) {
            float v = s[tt][j];
            if (chunk < 4) {
              const bool ok = (okm >> (tt * 4 + j)) & 1u;
              v = ok ? (v + bias[boff + dco[tt][j]]) : -1e30f;
            }
            s[tt][j] = v;
            mx = fmaxf(mx, v);
          }
        mx = fmaxf(mx, __shfl_xor(mx, 16));
        mx = fmaxf(mx, __shfl_xor(mx, 32));
        const float m_new = fmaxf(m_run, mx);
        const float sc = __expf(m_run - m_new);
        m_run = m_new;
        float ps = 0.f;
#pragma unroll
        for (int tt = 0; tt < 2; ++tt)
#pragma unroll
          for (int j = 0; j < 4; ++j) {
            float v = s[tt][j];
            float pv = (v > -1e29f) ? __expf(v - m_new) : 0.f;
            s[tt][j] = pv;
            ps += pv;
          }
        l_run = l_run * sc + ps;
#pragma unroll
        for (int mt = 0; mt < 4; ++mt) O[mt] *= sc;
        u32x2 p0 = pack4(s[0][0], s[0][1], s[0][2], s[0][3]);
        u32x2 p1 = pack4(s[1][0], s[1][1], s[1][2], s[1][3]);
        u32x4 pb = {p0.x, p0.y, p1.x, p1.y};
        bf16x8 bfr = __builtin_bit_cast(bf16x8, pb);
#pragma unroll
        for (int mt = 0; mt < 4; ++mt) {
          const u16* vp = Vt + (mt * 16 + l15) * 136 + kb + g * 4;
          u32x2 a0 = *(const u32x2*)vp;
          u32x2 a1 = *(const u32x2*)(vp + 16);
          u32x4 ab = {a0.x, a0.y, a1.x, a1.y};
          O[mt] = MFMA(__builtin_bit_cast(bf16x8, ab), bfr, O[mt]);
        }
      }
    }
    l_run += __shfl_xor(l_run, 16);
    l_run += __shfl_xor(l_run, 32);
    const float inv = 1.f / l_run;
    u16* o = (u16*)(p.ws + OFF_NAQ) + (long)(b * 4096 + r * 64 + qc) * 512 + head * 64 + g * 4;
#pragma unroll
    for (int mt = 0; mt < 4; ++mt)
      *(u32x2*)(o + mt * 16) = pack4(O[mt][0] * inv, O[mt][1] * inv, O[mt][2] * inv, O[mt][3] * inv);
  }
}

struct ScanRegs { u32x4 k0, k1, k2, k3, k4, k5, k6, k7, v0, v1, v2, v3; };

__device__ __forceinline__ void scan_issue(const Params& p, int b, int h, int dir, int s, int step, int tid, ScanRegs& R) {
  const bool isctx = step < 2;
  const int c = isctx ? (dir ? 1 - step : step) : (dir ? 31 - (step - 2) : step - 2);
  const int row = tid >> 4, cc = (tid & 15) * 8;
  const u16* kb; const u16* vb; long st;
  if (isctx) {
    kb = (const u16*)(p.ws + (dir ? OFF_CKTB : OFF_CKTF)) + ((long)((b * 4 + h) * 128 + row)) * 256 + c * 128 + cc;
    vb = (const u16*)(p.ws + OFF_CRVT) + ((long)((b * 4 + h) * 256 + s * 64 + row)) * 256 + c * 128 + cc;
    st = 16L * 256;
  } else {
    kb = (const u16*)(p.ws + (dir ? OFF_KTB : OFF_KTF)) + ((long)((b * 4 + h) * 128 + row)) * 4096 + c * 128 + cc;
    vb = (const u16*)(p.ws + OFF_RVT) + ((long)((b * 4 + h) * 256 + s * 64 + row)) * 4096 + c * 128 + cc;
    st = 16L * 4096;
  }
  R.k0 = *(const u32x4*)(kb); R.k1 = *(const u32x4*)(kb + st); R.k2 = *(const u32x4*)(kb + 2 * st); R.k3 = *(const u32x4*)(kb + 3 * st);
  R.k4 = *(const u32x4*)(kb + 4 * st); R.k5 = *(const u32x4*)(kb + 5 * st); R.k6 = *(const u32x4*)(kb + 6 * st); R.k7 = *(const u32x4*)(kb + 7 * st);
  R.v0 = *(const u32x4*)(vb); R.v1 = *(const u32x4*)(vb + st); R.v2 = *(const u32x4*)(vb + 2 * st); R.v3 = *(const u32x4*)(vb + 3 * st);
}

__device__ __forceinline__ void scan_step(const Params& p, ScanRegs& R, f32x4 (&S)[8], int b, int h, int dir, int s, int step,
                                          float gL, u16* Kt, u16* Vs, int tid) {
  const int lane = tid & 63, w = tid >> 6, l15 = lane & 15, g = lane >> 4;
  const int row = tid >> 4, cc = (tid & 15) * 8;
  const bool isctx = step < 2;
  const int c = isctx ? (dir ? 1 - step : step) : (dir ? 31 - (step - 2) : step - 2);
  if (!isctx) {
    u16* dst = (u16*)p.out + ((((long)(b * 4 + h) * 32 + c) * 2 + dir) * 32768L) + (long)(s * 64 + w * 16 + l15) * 128 + g * 4;
#pragma unroll
    for (int i = 0; i < 8; ++i) *(u32x2*)(dst + i * 16) = pack4(S[i][0], S[i][1], S[i][2], S[i][3]);
  }
  *(u32x4*)(Kt + row * 136 + cc) = R.k0; *(u32x4*)(Kt + (row + 16) * 136 + cc) = R.k1;
  *(u32x4*)(Kt + (row + 32) * 136 + cc) = R.k2; *(u32x4*)(Kt + (row + 48) * 136 + cc) = R.k3;
  *(u32x4*)(Kt + (row + 64) * 136 + cc) = R.k4; *(u32x4*)(Kt + (row + 80) * 136 + cc) = R.k5;
  *(u32x4*)(Kt + (row + 96) * 136 + cc) = R.k6; *(u32x4*)(Kt + (row + 112) * 136 + cc) = R.k7;
  *(u32x4*)(Vs + row * 136 + cc) = R.v0; *(u32x4*)(Vs + (row + 16) * 136 + cc) = R.v1;
  *(u32x4*)(Vs + (row + 32) * 136 + cc) = R.v2; *(u32x4*)(Vs + (row + 48) * 136 + cc) = R.v3;
  if (step + 2 < 34) scan_issue(p, b, h, dir, s, step + 2, tid, R);
  __syncthreads();
#pragma unroll
  for (int i = 0; i < 8; ++i) S[i] *= gL;
#pragma unroll
  for (int ks = 0; ks < 4; ++ks) {
    bf16x8 bfr = *(const bf16x8*)(Vs + (w * 16 + l15) * 136 + ks * 32 + g * 8);
#pragma unroll
    for (int i = 0; i < 8; ++i) {
      bf16x8 a = *(const bf16x8*)(Kt + (i * 16 + l15) * 136 + ks * 32 + g * 8);
      S[i] = MFMA(a, bfr, S[i]);
    }
  }
}

__device__ __forceinline__ void scan_unit(const Params& p, int u, char* smem, int tid) {
  const int s = u & 3, dir = (u >> 2) & 1, h = (u >> 3) & 3, b = u >> 5;
  u16* Kt = (u16*)smem;
  u16* Vs = Kt + 128 * 136;
  const float lg = dir ? p.ldb[h] : p.ldf[h];
  const float gL = expf(lg * 128.f);
  f32x4 S[8];
#pragma unroll
  for (int i = 0; i < 8; ++i) S[i] = f32x4{0.f, 0.f, 0.f, 0.f};
  ScanRegs RA, RB;
  scan_issue(p, b, h, dir, s, 0, tid, RA);
  scan_issue(p, b, h, dir, s, 1, tid, RB);
#pragma unroll 1
  for (int sp = 0; sp < 17; ++sp) {
    const int step = 2 * sp;
    __syncthreads();
    scan_step(p, RA, S, b, h, dir, s, step, gL, Kt, Vs, tid);
    __syncthreads();
    scan_step(p, RB, S, b, h, dir, s, step + 1, gL, Kt, Vs, tid);
  }
}

__device__ __forceinline__ void stage_q_scaled(u16* Qs, const u16* rq, long t0, int h, const float* tab, int mode, int tid) {
#pragma unroll
  for (int i = 0; i < 8; ++i) {
    int idx = tid + i * 256;
    int row = idx >> 4, cc = (idx & 15) * 8;
    u32x4 v = *(const u32x4*)(rq + (t0 + row) * 512 + h * 128 + cc);
    if (mode != 0) {
      float sc = (mode == 1) ? tab[row + 1] : tab[128 - row];
#pragma unroll
      for (int q = 0; q < 4; ++q) {
        float a = bf2f((u16)(v[q] & 0xffffu)) * sc;
        float bq = bf2f((u16)(v[q] >> 16)) * sc;
        v[q] = pack2(a, bq);
      }
    }
    *(u32x4*)(Qs + row * 136 + cc) = v;
  }
}

__device__ __forceinline__ void intra_unit(const Params& p, int u, char* smem, int tid) {
  const int c = u & 31, h = (u >> 5) & 3, b = u >> 7;
  u16* Qs = (u16*)smem;
  u16* Ks = Qs + 128 * 136;
  const int lane = tid & 63, w = tid >> 6, l15 = lane & 15, g = lane >> 4;
  const long t0 = (long)b * 4096 + c * 128;
  const u16* rq = (const u16*)(p.ws + OFF_RQ);
  const u16* rk = (const u16*)(p.ws + OFF_RK);
  const u16* rvT = (const u16*)(p.ws + OFF_RVT);
  const u16* sbuf = (const u16*)p.out;
  u16* oraw = (u16*)(p.ws + OFF_ORAW);
  const float lgf = p.ldf[h], lgb = p.ldb[h];
  float* tF = (float*)(smem + 69632);
  float* tFi = tF + 132;
  float* tB = tFi + 132;
  float* tBi = tB + 132;
  __syncthreads();
  if (tid < 129) {
    tF[tid] = expf(lgf * (float)tid);
    tFi[tid] = expf(-lgf * (float)tid);
    tB[tid] = expf(lgb * (float)tid);
    tBi[tid] = expf(-lgb * (float)tid);
  }
  stage_q_scaled(Qs, rq, t0, h, nullptr, 0, tid);
#pragma unroll
  for (int i = 0; i < 8; ++i) {
    int idx = tid + i * 256;
    int row = idx >> 4, cc = (idx & 15) * 8;
    *(u32x4*)(Ks + row * 136 + cc) = *(const u32x4*)(rk + (t0 + row) * 512 + h * 128 + cc);
  }
  __syncthreads();
  {
    f32x4 P[2][8];
#pragma unroll
    for (int i = 0; i < 2; ++i)
#pragma unroll
      for (int j = 0; j < 8; ++j) P[i][j] = f32x4{0.f, 0.f, 0.f, 0.f};
#pragma unroll 1
    for (int ks = 0; ks < 4; ++ks) {
      bf16x8 a0 = *(const bf16x8*)(Qs + (32 * w + l15) * 136 + ks * 32 + g * 8);
      bf16x8 a1 = *(const bf16x8*)(Qs + (32 * w + 16 + l15) * 136 + ks * 32 + g * 8);
#pragma unroll
      for (int nt = 0; nt < 8; ++nt) {
        bf16x8 bb = *(const bf16x8*)(Ks + (nt * 16 + l15) * 136 + ks * 32 + g * 8);
        P[0][nt] = MFMA(a0, bb, P[0][nt]);
        P[1][nt] = MFMA(a1, bb, P[1][nt]);
      }
    }
    __syncthreads();
#pragma unroll
    for (int mt = 0; mt < 2; ++mt)
#pragma unroll
      for (int nt = 0; nt < 8; ++nt)
#pragma unroll
        for (int j = 0; j < 4; ++j) {
          int l = 32 * w + mt * 16 + g * 4 + j;
          int m = nt * 16 + l15;
          float d = (m <= l) ? tF[l] * tFi[m] : tB[m] * tBi[l];
          Ks[l * 136 + m] = f2bf(P[mt][nt][j] * d);
        }
  }
#pragma unroll 1
  for (int hf = 0; hf < 2; ++hf) {
    const int dvb = hf * 128 + w * 32;
    stage_q_scaled(Qs, rq, t0, h, tF, 1, tid);
    __syncthreads();
    f32x4 O[8][2];
#pragma unroll
    for (int i = 0; i < 8; ++i) { O[i][0] = f32x4{0.f, 0.f, 0.f, 0.f}; O[i][1] = f32x4{0.f, 0.f, 0.f, 0.f}; }
    {
      const u16* vb = rvT + ((long)((b * 4 + h) * 256 + dvb + l15)) * 4096 + c * 128 + g * 8;
#pragma unroll
      for (int ks = 0; ks < 4; ++ks) {
        bf16x8 bf0 = *(const bf16x8*)(vb + ks * 32);
        bf16x8 bf1 = *(const bf16x8*)(vb + 16L * 4096 + ks * 32);
#pragma unroll
        for (int mt = 0; mt < 8; ++mt) {
          bf16x8 a = *(const bf16x8*)(Ks + (mt * 16 + l15) * 136 + ks * 32 + g * 8);
          O[mt][0] = MFMA(a, bf0, O[mt][0]);
          O[mt][1] = MFMA(a, bf1, O[mt][1]);
        }
      }
    }
    {
      const u16* sb = sbuf + ((((long)(b * 4 + h) * 32 + c) * 2 + 0) * 32768L) + (long)(dvb + l15) * 128 + g * 8;
#pragma unroll
      for (int ks = 0; ks < 4; ++ks) {
        bf16x8 bf0 = *(const bf16x8*)(sb + ks * 32);
        bf16x8 bf1 = *(const bf16x8*)(sb + 16 * 128 + ks * 32);
#pragma unroll
        for (int mt = 0; mt < 8; ++mt) {
          bf16x8 a = *(const bf16x8*)(Qs + (mt * 16 + l15) * 136 + ks * 32 + g * 8);
          O[mt][0] = MFMA(a, bf0, O[mt][0]);
          O[mt][1] = MFMA(a, bf1, O[mt][1]);
        }
      }
    }
    __syncthreads();
    stage_q_scaled(Qs, rq, t0, h, tB, 2, tid);
    __syncthreads();
    {
      const u16* sb = sbuf + ((((long)(b * 4 + h) * 32 + c) * 2 + 1) * 32768L) + (long)(dvb + l15) * 128 + g * 8;
#pragma unroll
      for (int ks = 0; ks < 4; ++ks) {
        bf16x8 bf0 = *(const bf16x8*)(sb + ks * 32);
        bf16x8 bf1 = *(const bf16x8*)(sb + 16 * 128 + ks * 32);
#pragma unroll
        for (int mt = 0; mt < 8; ++mt) {
          bf16x8 a = *(const bf16x8*)(Qs + (mt * 16 + l15) * 136 + ks * 32 + g * 8);
          O[mt][0] = MFMA(a, bf0, O[mt][0]);
          O[mt][1] = MFMA(a, bf1, O[mt][1]);
        }
      }
    }
    __syncthreads();
#pragma unroll
    for (int mt = 0; mt < 8; ++mt)
#pragma unroll
      for (int nt = 0; nt < 2; ++nt)
#pragma unroll
        for (int j = 0; j < 4; ++j) Qs[(mt * 16 + g * 4 + j) * 136 + w * 32 + nt * 16 + l15] = f2bf(O[mt][nt][j]);
    __syncthreads();
#pragma unroll
    for (int i = 0; i < 8; ++i) {
      int idx = tid + i * 256;
      int row = idx >> 4, cc = (idx & 15) * 8;
      *(u32x4*)(oraw + (t0 + row) * 1024 + h * 256 + hf * 128 + cc) = *(const u32x4*)(Qs + row * 136 + cc);
    }
    __syncthreads();
  }
  u16* rg = (u16*)(p.ws + OFF_RG);
#pragma unroll 1
  for (int rb = 0; rb < 4; ++rb) {
    u32x2 ovv[8], gvv[8];
#pragma unroll
    for (int r = 0; r < 8; ++r) {
      const long l = t0 + 32 * w + rb * 8 + r;
      ovv[r] = *(const u32x2*)(oraw + l * 1024 + h * 256 + lane * 4);
      gvv[r] = *(const u32x2*)(rg + l * 1024 + h * 256 + lane * 4);
    }
#pragma unroll
    for (int r = 0; r < 8; ++r) {
      const long l = t0 + 32 * w + rb * 8 + r;
      const u32x2 ov = ovv[r], gv = gvv[r];
      float x0 = bf2f((u16)(ov.x & 0xffffu)), x1 = bf2f((u16)(ov.x >> 16)), x2 = bf2f((u16)(ov.y & 0xffffu)), x3 = bf2f((u16)(ov.y >> 16));
      float mu = wave_sum(x0 + x1 + x2 + x3) * (1.f / 256.f);
      float d0 = x0 - mu, d1 = x1 - mu, d2 = x2 - mu, d3 = x3 - mu;
      float var = wave_sum(d0 * d0 + d1 * d1 + d2 * d2 + d3 * d3) * (1.f / 256.f);
      float rstd = rsqrtf(var + 1e-6f);
      float g0 = bf2f((u16)(gv.x & 0xffffu)), g1 = bf2f((u16)(gv.x >> 16)), g2 = bf2f((u16)(gv.y & 0xffffu)), g3 = bf2f((u16)(gv.y >> 16));
      *(u32x2*)(rg + l * 1024 + h * 256 + lane * 4) = pack4(d0 * rstd * siluf_(g0), d1 * rstd * siluf_(g1), d2 * rstd * siluf_(g2), d3 * rstd * siluf_(g3));
    }
  }
}

__device__ __forceinline__ GA merge_ga(const Params& p, int step, int m0, int n0) {
  GA g;
  if (step == 0)      { g.A = (const u16*)(p.ws + OFF_HX) + (long)m0 * 1024;  g.B = (const u16*)(p.ws + OFF_WIN) + (long)(4608 + n0) * 1024; g.lda = 1024; g.ldb = 1024; }
  else if (step == 1) { g.A = (const u16*)(p.ws + OFF_NAQ) + (long)m0 * 512;  g.B = (const u16*)(p.ws + OFF_WPNA) + (long)n0 * 512;          g.lda = 512;  g.ldb = 512; }
  else if (step == 2) { g.A = (const u16*)(p.ws + OFF_HX) + (long)m0 * 1024;  g.B = (const u16*)(p.ws + OFF_WIN) + (long)(5632 + n0) * 1024; g.lda = 1024; g.ldb = 1024; }
  else                { g.A = (const u16*)(p.ws + OFF_RG) + (long)m0 * 1024;  g.B = (const u16*)(p.ws + OFF_WPRET) + (long)n0 * 1024;        g.lda = 1024; g.ldb = 1024; }
  return g;
}
#define F32_EPILOGUE(BODY)                                                              \
  {                                                                                     \
    float* st_ = (float*)(smem + WST_OFF + wid * WST_BYTES);                            \
    _Pragma("unroll") for (int ps_ = 0; ps_ < 4; ++ps_) {                               \
      _Pragma("unroll") for (int m2_ = 0; m2_ < 2; ++m2_)                               \
        _Pragma("unroll") for (int n_ = 0; n_ < 4; ++n_)                                \
          *(f32x4*)(st_ + (m2_ * 16 + fr) * 68 + n_ * 16 + fq * 4) = acc[ps_ * 2 + m2_][n_]; \
      _Pragma("unroll") for (int i_ = 0; i_ < 8; ++i_) {                                \
        const int id_ = lane + i_ * 64;                                                 \
        const int rl_ = id_ >> 4, c4_ = (id_ & 15) * 4;                                 \
        const int rt = wr * 128 + ps_ * 32 + rl_, ct = wc * 64 + c4_;                   \
        const f32x4 a4 = *(const f32x4*)(st_ + rl_ * 68 + c4_);                         \
        BODY                                                                            \
      }                                                                                 \
    }                                                                                   \
  }

template <int STEP>
__device__ __forceinline__ void merge_step(const Params& p, int m0, int n0, char* smem, bool pre, GA nx) {
  EPI_IDS;
  u16* park1 = (u16*)p.out;
  u16* park2 = (u16*)(p.ws + OFF_PARK2);
  u16* merged = (u16*)(p.ws + OFF_MERGED);
  f32x4 acc[8][4];
  zero_acc(acc);
  {
    GA g = merge_ga(p, STEP, m0, n0);
    gemm256<true>(acc, g.A, g.lda, g.B, g.ldb, (STEP == 1) ? 512 : 1024, smem, pre, nx);
  }
  if (STEP == 0 || STEP == 2) {
    u16* dst = (STEP == 0) ? park1 : park2;
    F32_EPILOGUE({
      *(u32x2*)(dst + (long)(m0 + rt) * 1024 + n0 + ct) = pack4(sigmoidf_(a4[0]), sigmoidf_(a4[1]), sigmoidf_(a4[2]), sigmoidf_(a4[3]));
    })
  } else if (STEP == 1) {
    F32_EPILOGUE({
      u16* d = park1 + (long)(m0 + rt) * 1024 + n0 + ct;
      u32x2 g2 = *(const u32x2*)d;
      *(u32x2*)d = pack4(bf2f((u16)(g2.x & 0xffffu)) * a4[0], bf2f((u16)(g2.x >> 16)) * a4[1],
                         bf2f((u16)(g2.y & 0xffffu)) * a4[2], bf2f((u16)(g2.y >> 16)) * a4[3]);
    })
  } else {
    F32_EPILOGUE({
      const long off = (long)(m0 + rt) * 1024 + n0 + ct;
      u32x2 a = *(const u32x2*)(park1 + off);
      u32x2 gb = *(const u32x2*)(park2 + off);
      *(u32x2*)(merged + off) = pack4(bf2f((u16)(a.x & 0xffffu)) + bf2f((u16)(gb.x & 0xffffu)) * a4[0],
                                      bf2f((u16)(a.x >> 16)) + bf2f((u16)(gb.x >> 16)) * a4[1],
                                      bf2f((u16)(a.y & 0xffffu)) + bf2f((u16)(gb.y & 0xffffu)) * a4[2],
                                      bf2f((u16)(a.y >> 16)) + bf2f((u16)(gb.y >> 16)) * a4[3]);
    })
  }
  asm volatile("" ::: "memory");
}

__device__ __forceinline__ GA outproj_ga(const Params& p, int id) {
  GA g; g.A = nullptr; g.B = nullptr; g.lda = 1024; g.ldb = 1024;
  if (id < 512) {
    int mt_, nt_;
    tile_mn(id, 4, mt_, nt_);
    g.A = (const u16*)(p.ws + OFF_MERGED) + (long)mt_ * 256 * 1024;
    g.B = (const u16*)(p.ws + OFF_WOUT) + (long)nt_ * 256 * 1024;
  }
  return g;
}
__device__ __forceinline__ void outproj_tile(const Params& p, int id, char* smem, bool pre, GA nx) {
  int mt_, nt_;
  tile_mn(id, 4, mt_, nt_);
  const int m0 = mt_ * 256, n0 = nt_ * 256;
  EPI_IDS;
  f32x4 acc[8][4];
  zero_acc(acc);
  gemm256<true>(acc, (const u16*)(p.ws + OFF_MERGED) + (long)m0 * 1024, 1024, (const u16*)(p.ws + OFF_WOUT) + (long)n0 * 1024, 1024, 1024, smem, pre, nx);
  const float* mod = (const float*)(p.ws + OFF_MOD);
  const int bb = m0 >> 12;
  F32_EPILOGUE({
    const long off = (long)(m0 + rt) * 1024 + n0 + ct;
    const f32x4 xv = __builtin_nontemporal_load((const f32x4*)(p.x + off));
    float4 gv = *(const float4*)(mod + bb * 6144 + 2048 + n0 + ct);
    f32x4 o;
    o[0] = xv[0] + gv.x * a4[0];
    o[1] = xv[1] + gv.y * a4[1];
    o[2] = xv[2] + gv.z * a4[2];
    o[3] = xv[3] + gv.w * a4[3];
    __builtin_nontemporal_store(o, (f32x4*)(p.out + off));
  })
}

__device__ __forceinline__ int ffn_h(int half) { return half ? 1280 : 1536; }
__device__ __forceinline__ int ffn_a0(int half) { return half ? 1536 : 0; }

__device__ __forceinline__ GA up_ga(const Params& p, int half, int id) {
  const int H = ffn_h(half), a0 = ffn_a0(half), NT = 2 * H / 256, NA_ = H / 256;
  GA g; g.A = nullptr; g.B = nullptr; g.lda = 1024; g.ldb = 1024;
  if (id < 128 * NT) {
    int mt_, j;
    tile_mn(id, NT, mt_, j);
    const int wrow = (j < NA_) ? (a0 + j * 256) : (2816 + a0 + (j - NA_) * 256);
    g.A = (const u16*)(p.ws + OFF_HX) + (long)mt_ * 256 * 1024;
    g.B = (const u16*)(p.ws + OFF_WUP) + (long)wrow * 1024;
  }
  return g;
}
__device__ __forceinline__ void up_tile(const Params& p, int half, int id, char* smem, bool pre, GA nx) {
  const int H = ffn_h(half), a0 = ffn_a0(half), NT = 2 * H / 256, NA_ = H / 256;
  int mt_, j;
  tile_mn(id, NT, mt_, j);
  const int m0 = mt_ * 256;
  const int wrow = (j < NA_) ? (a0 + j * 256) : (2816 + a0 + (j - NA_) * 256);
  EPI_IDS;
  f32x4 acc[8][4];
  zero_acc(acc);
  gemm256<true>(acc, (const u16*)(p.ws + OFF_HX) + (long)m0 * 1024, 1024, (const u16*)(p.ws + OFF_WUP) + (long)wrow * 1024, 1024, 1024, smem, pre, nx);
  u16* uh = (u16*)(p.ws + OFF_UH);
  const long us = 2 * H;
  wave_store_nat_bf16(acc, smem, uh + (long)(m0 + wr * 128) * us + j * 256 + wc * 64, us, 1.f, wid, lane, fr, fq);
}

__device__ __forceinline__ void act_unit(const Params& p, int half, int u, int tid) {
  const int H = ffn_h(half), a0 = ffn_a0(half), CH = H / 8;
  const int item = u * 256 + tid;
  if (item >= 4096 * CH) return;
  const int seg = item / CH, ch = item % CH;
  const int t0 = seg * 8;
  const int f = ch * 8;
  const int ca = a0 + f, cv = 2816 + a0 + f;
  const long us = 2 * H;
  const u16* uh = (const u16*)(p.ws + OFF_UH);
  u16* hact = (u16*)(p.ws + OFF_HACT);
  const bool has_prev = (t0 & 4095) != 0, has_next = ((t0 + 8) & 4095) != 0;
  const u32x4 z = {0u, 0u, 0u, 0u};
  u32x4 ra[10], rv[10];
#pragma unroll
  for (int i = 0; i < 10; ++i) {
    const bool ok = (i == 0) ? has_prev : ((i == 9) ? has_next : true);
    const long tr = ok ? (long)(t0 - 1 + i) : (long)t0;
    ra[i] = __builtin_nontemporal_load((const u32x4*)(uh + tr * us + f));
    rv[i] = __builtin_nontemporal_load((const u32x4*)(uh + tr * us + H + f));
    if (!ok) { ra[i] = z; rv[i] = z; }
  }
  float wa[3][8], wv[3][8], ba[8], bv[8];
#pragma unroll
  for (int i = 0; i < 3; ++i)
#pragma unroll
    for (int q = 0; q < 8; ++q) {
      wa[i][q] = p.conv_w[i * 5632 + ca + q];
      wv[i][q] = p.conv_w[i * 5632 + cv + q];
    }
#pragma unroll
  for (int q = 0; q < 8; ++q) { ba[q] = p.conv_b[ca + q]; bv[q] = p.conv_b[cv + q]; }
#pragma unroll
  for (int i = 0; i < 8; ++i) {
    unsigned o[4];
#pragma unroll
    for (int q = 0; q < 4; ++q) {
      float a_lo = bf2f((u16)(ra[i][q] & 0xffffu)) * wa[0][2 * q] + bf2f((u16)(ra[i + 1][q] & 0xffffu)) * wa[1][2 * q] + bf2f((u16)(ra[i + 2][q] & 0xffffu)) * wa[2][2 * q] + ba[2 * q];
      float a_hi = bf2f((u16)(ra[i][q] >> 16)) * wa[0][2 * q + 1] + bf2f((u16)(ra[i + 1][q] >> 16)) * wa[1][2 * q + 1] + bf2f((u16)(ra[i + 2][q] >> 16)) * wa[2][2 * q + 1] + ba[2 * q + 1];
      float v_lo = bf2f((u16)(rv[i][q] & 0xffffu)) * wv[0][2 * q] + bf2f((u16)(rv[i + 1][q] & 0xffffu)) * wv[1][2 * q] + bf2f((u16)(rv[i + 2][q] & 0xffffu)) * wv[2][2 * q] + bv[2 * q];
      float v_hi = bf2f((u16)(rv[i][q] >> 16)) * wv[0][2 * q + 1] + bf2f((u16)(rv[i + 1][q] >> 16)) * wv[1][2 * q + 1] + bf2f((u16)(rv[i + 2][q] >> 16)) * wv[2][2 * q + 1] + bv[2 * q + 1];
      o[q] = pack2(siluf_(a_lo) * v_lo, siluf_(a_hi) * v_hi);
    }
    *(u32x4*)(hact + (long)(t0 + i) * 2816 + a0 + f) = u32x4{o[0], o[1], o[2], o[3]};
  }
}
__device__ __forceinline__ int act_units(int half) { return 4096 * (ffn_h(half) / 8) / 256; }

__device__ __forceinline__ GA down_ga(const Params& p, int half, int id) {
  const int H = 2816, a0 = 0; (void)half;
  GA g; g.A = nullptr; g.B = nullptr; g.lda = H; g.ldb = 2816;
  if (id < 512) {
    int mt_, nt_;
    tile_mn(id, 4, mt_, nt_);
    g.A = (const u16*)(p.ws + OFF_HACT) + (long)mt_ * 256 * H;
    g.B = (const u16*)(p.ws + OFF_WDOWN) + (long)nt_ * 256 * 2816 + a0;
  }
  return g;
}
__device__ __forceinline__ void down_tile(const Params& p, int half, int id, char* smem, bool pre, GA nx) {
  const int H = 2816, a0 = 0; (void)half;
  int mt_, nt_;
  tile_mn(id, 4, mt_, nt_);
  const int m0 = mt_ * 256, n0 = nt_ * 256;
  EPI_IDS;
  f32x4 acc[8][4];
  zero_acc(acc);
  gemm256<true>(acc, (const u16*)(p.ws + OFF_HACT) + (long)m0 * H, H, (const u16*)(p.ws + OFF_WDOWN) + (long)n0 * 2816 + a0, 2816, H, smem, pre, nx);
  const float* mod = (const float*)(p.ws + OFF_MOD);
  const int bb = m0 >> 12;
  F32_EPILOGUE({
    const long off = (long)(m0 + rt) * 1024 + n0 + ct;
    f32x4 xv = __builtin_nontemporal_load((const f32x4*)(p.out + off));
    float4 gv = *(const float4*)(mod + bb * 6144 + 5120 + n0 + ct);
    xv[0] += gv.x * a4[0];
    xv[1] += gv.y * a4[1];
    xv[2] += gv.z * a4[2];
    xv[3] += gv.w * a4[3];
    __builtin_nontemporal_store(xv, (f32x4*)(p.out + off));
  })
}

#define XB_TMO      128
#define XB_XCNT(j)  (256  + 64 * (j))
#define XB_XSUB(j)  (1280 + 64 * (j))
#define XB_XGEN(j)  (2304 + 64 * (j))
#define XB_TOP      3328
#define XB_TOPGEN   3392
#define XCD_BAR_WORDS 3456
#define XB_SPIN_CAP (1u << 18)
#define LAS __attribute__((address_space(3)))

__device__ __forceinline__ unsigned xb_ld(unsigned* p)              { return __hip_atomic_load(p, __ATOMIC_RELAXED, __HIP_MEMORY_SCOPE_AGENT); }
__device__ __forceinline__ unsigned xb_add(unsigned* p, unsigned v) { return __hip_atomic_fetch_add(p, v, __ATOMIC_RELAXED, __HIP_MEMORY_SCOPE_AGENT); }
__device__ __forceinline__ unsigned xb_xcc_id() { return (unsigned)__builtin_amdgcn_s_getreg((3 << 11) | 20) & 0xFu; }
#define XB_SPIN(cond, bar) do { unsigned _sp = 0; while (cond) { __builtin_amdgcn_s_sleep(1); \
    if ((++_sp & 255u) == 0u) { if (xb_ld(&(bar)[XB_TMO])) break; if (_sp > XB_SPIN_CAP) { atomicAdd(&(bar)[XB_TMO], 1u); break; } } } } while (0)

struct XcdBarrier {
    unsigned* bar; unsigned x;
    volatile LAS unsigned* st;
};

__device__ __forceinline__ XcdBarrier xcd_barrier_post(unsigned* bar, volatile LAS unsigned* st) {
    XcdBarrier b; b.bar = bar; b.x = xb_xcc_id(); b.st = st;
    if (threadIdx.x == 0) (void)xb_add(&bar[XB_XCNT(b.x)], 1u);
    return b;
}
__device__ __forceinline__ void xcd_barrier_complete(unsigned* bar, unsigned x, unsigned& nloc, unsigned& nx) {
    const unsigned G = gridDim.x * gridDim.y * gridDim.z;
    unsigned sum, cnt, mine, sp = 0u;
    for (;;) {
        sum = 0u; cnt = 0u; mine = 0u;
#pragma unroll
        for (unsigned j = 0; j < 16; ++j) { const unsigned c = xb_ld(&bar[XB_XCNT(j)]); sum += c; cnt += (c > 0u) ? 1u : 0u; mine = (j == x) ? c : mine; }
        if (sum == G) break;
        __builtin_amdgcn_s_sleep(1);
        if ((++sp & 255u) == 0u) { if (xb_ld(&bar[XB_TMO])) break; if (sp > XB_SPIN_CAP) { atomicAdd(&bar[XB_TMO], 1u); break; } }
    }
    nloc = mine > 0u ? mine : 1u; nx = cnt > 0u ? cnt : 1u;
}

__device__ __forceinline__ void xcd_barrier(const XcdBarrier& b) {
    asm volatile("s_waitcnt vmcnt(0)" ::: "memory");
    __syncthreads();
    if (threadIdx.x == 0) {
        unsigned* bar = b.bar;
        __builtin_amdgcn_s_waitcnt(0);
        unsigned nloc = b.st[0], nx = b.st[1];
        if (nloc == 0u) { xcd_barrier_complete(bar, b.x, nloc, nx); b.st[0] = nloc; b.st[1] = nx; }
        const unsigned old = xb_add(&bar[XB_XSUB(b.x)], 1u);
        const unsigned gen = old / nloc;
        if (old + 1u == (gen + 1u) * nloc) {
            __builtin_amdgcn_fence(__ATOMIC_RELEASE, "agent");
            asm volatile("s_waitcnt vmcnt(0)" ::: "memory");
            const unsigned og = xb_add(&bar[XB_TOP], 1u);
            const unsigned tg = og / nx;
            if (og + 1u == (tg + 1u) * nx) xb_add(&bar[XB_TOPGEN], 1u);
            else XB_SPIN(xb_ld(&bar[XB_TOPGEN]) == tg, bar);
            __builtin_amdgcn_fence(__ATOMIC_ACQUIRE, "agent");
            xb_add(&bar[XB_XGEN(b.x)], 1u);
            asm volatile("s_waitcnt vmcnt(0)" ::: "memory");
        } else {
            XB_SPIN(xb_ld(&bar[XB_XGEN(b.x)]) == gen, bar);
            __builtin_amdgcn_fence(__ATOMIC_ACQUIRE, "agent");
            asm volatile("s_waitcnt vmcnt(0)" ::: "memory");
        }
    }
    __syncthreads();
}


__global__ void __launch_bounds__(512, 2) mega(Params pk) {
  extern __shared__ __attribute__((aligned(1024))) char smem[];
  Params& p_sh = *(Params*)(smem + PARAM_OFF);
  if (threadIdx.x == 0) {
    p_sh.x = pk.x; p_sh.c = pk.c; p_sh.ctx = pk.ctx; p_sh.c_ctx = pk.c_ctx; p_sh.w_ada = pk.w_ada; p_sh.b_ada = pk.b_ada;
    p_sh.norm1_g = pk.norm1_g; p_sh.w_in = pk.w_in; p_sh.na_rpb = pk.na_rpb; p_sh.ldf = pk.ldf; p_sh.ldb = pk.ldb;
    p_sh.w_pna = pk.w_pna; p_sh.w_pret = pk.w_pret; p_sh.w_out = pk.w_out; p_sh.norm2_g = pk.norm2_g; p_sh.w_up = pk.w_up;
    p_sh.conv_w = pk.conv_w; p_sh.conv_b = pk.conv_b; p_sh.w_down = pk.w_down; p_sh.final_g = pk.final_g;
    p_sh.out = pk.out; p_sh.ws = pk.ws;
  }
  volatile LAS unsigned* xb_st = (volatile LAS unsigned*)(smem + PARAM_OFF + 192);
  if (threadIdx.x == 0) { xb_st[0] = 0u; xb_st[1] = 0u; }
  unsigned* xb_bar = (unsigned*)(pk.ws + WS_END);
  if (blockIdx.x == 0) for (int i = threadIdx.x; i < XCD_BAR_WORDS; i += 512) xb_bar[i] = 0u;
  __syncthreads();
  const Params& p = p_sh;
  cg::grid_group grid = cg::this_grid();
  const int nb = gridDim.x, bid = blockIdx.x;
#define VB_IDS                                                                        \
  int tid_ = threadIdx.x; asm volatile("" : "+v"(tid_));                              \
  const int hb = tid_ >> 8, vtid = tid_ & 255, vb = bid * 2 + hb, nvb = nb * 2, w8 = tid_ >> 6; \
  char* hsm = smem + hb * HALF_LDS;                                                   \
  const float* mod = (const float*)(p.ws + OFF_MOD);                                  \
  (void)vtid; (void)vb; (void)nvb; (void)w8; (void)hsm; (void)mod
#define GSYNC()                                                                       \
  do {                                                                                \
    XcdBarrier b_;                                                                    \
    b_.bar = (unsigned*)(p.ws + WS_END);                                              \
    b_.st = (volatile LAS unsigned*)(smem + PARAM_OFF + 192);                         \
    b_.x = b_.st[2];                                                                  \
    xcd_barrier(b_);                                                                  \
  } while (0)

  { VB_IDS; for (int u = vb; u < P0_UNITS; u += nvb) p0_unit(p, (u < 192) ? (4416 + u) : ((u < 4608) ? (u - 192) : 4608), hsm, vtid); }
  grid.sync();
  {
    const XcdBarrier xb0 = xcd_barrier_post((unsigned*)(p.ws + WS_END), (volatile LAS unsigned*)(smem + PARAM_OFF + 192));
    if (threadIdx.x == 0) ((volatile LAS unsigned*)(smem + PARAM_OFF + 192))[2] = xb0.x;
    __syncthreads();
  }
  for (int u = bid; u < (T + TC) / 16; u += nb) {
    VB_IDS;
    int row = u * 16 + w8 * 2;
    if (row < T) {
      int b = row >> 12;
      rownorm2_bf16(p.x + (long)row * 1024, p.norm1_g, mod + b * 6144, mod + b * 6144 + 1024, (u16*)(p.ws + OFF_HX) + (long)row * 1024);
    } else {
      rownorm2_bf16(p.ctx + (long)(row - T) * 1024, p.norm1_g, mod + 8 * 6144, mod + 8 * 6144 + 1024, (u16*)(p.ws + OFF_HX) + (long)row * 1024);
    }
  }
  GSYNC();
  {
    bool pre = false;
    for (int u = bid; u < 2304 + 80; u += nb) { GA nx = inproj_ga(p, 1 << 30); inproj_tile(p, u, smem, pre, nx); pre = false; }
  }
  GSYNC();
  {
    VB_IDS;
    if (nb == 256) {
      if (bid < 128) {
        scan_unit(p, vb, hsm, vtid);
        na_run(p, 2816 + bid * 10 + hb, 2, 5, hsm, vtid);
      } else {
        na_run(p, (bid - 128) * 22 + hb, 2, 11, hsm, vtid);
      }
    } else {
      for (int u = vb; u < 256; u += nvb) scan_unit(p, u, hsm, vtid);
      int cnt = (4096 - vb + nvb - 1) / nvb;
      na_run(p, vb, nvb, cnt, hsm, vtid);
    }
  }
  GSYNC();
  { VB_IDS; for (int u = vb; u < 1024; u += nvb) intra_unit(p, u, hsm, vtid); }
  GSYNC();
  {
    bool pre = false;
    for (int u = bid; u < 512; u += nb) {
      int mt_, nt_;
      tile_mn(u, 4, mt_, nt_);
      const int m0 = mt_ * 256, n0 = nt_ * 256;
      GA nx; nx.A = nullptr; nx.B = nullptr; nx.lda = 1024; nx.ldb = 1024;
      merge_step<0>(p, m0, n0, smem, false, nx);
      merge_step<1>(p, m0, n0, smem, false, nx);
      merge_step<2>(p, m0, n0, smem, false, nx);
      merge_step<3>(p, m0, n0, smem, false, nx);
      (void)pre;
    }
  }
  GSYNC();
  {
    bool pre = false;
    for (int u = bid; u < 512; u += nb) { GA nx = outproj_ga(p, 1 << 30); outproj_tile(p, u, smem, pre, nx); pre = false; }
  }
  GSYNC();
  for (int u = bid; u < T / 16; u += nb) {
    VB_IDS;
    int row = u * 16 + w8 * 2;
    int b = row >> 12;
    rownorm2_bf16(p.out + (long)row * 1024, p.norm2_g, mod + b * 6144 + 3072, mod + b * 6144 + 4096, (u16*)(p.ws + OFF_HX) + (long)row * 1024);
  }
  GSYNC();
  {
    bool pre = false;
    for (int u = bid; u < 128 * 12; u += nb) { GA nx = up_ga(p, 0, 1 << 30); up_tile(p, 0, u, smem, pre, nx); pre = false; }
  }
  GSYNC();
  { VB_IDS; for (int u = vb; u < act_units(0); u += nvb) act_unit(p, 0, u, vtid); }
  GSYNC();
  {
    bool pre = false;
    for (int u = bid; u < 128 * 10; u += nb) { GA nx = up_ga(p, 1, 1 << 30); up_tile(p, 1, u, smem, pre, nx); pre = false; }
  }
  GSYNC();
  { VB_IDS; for (int u = vb; u < act_units(1); u += nvb) act_unit(p, 1, u, vtid); }
  GSYNC();
  {
    bool pre = false;
    for (int u = bid; u < 512; u += nb) { GA nx = down_ga(p, 1, 1 << 30); down_tile(p, 1, u, smem, pre, nx); pre = false; }
  }
  GSYNC();
  for (int u = bid; u < T / 16; u += nb) {
    VB_IDS;
    int row = u * 16 + w8 * 2;
    const int lane = tid_ & 63;
    float* src = p.out + (long)row * 1024;
    float4 v[2][4];
#pragma unroll
    for (int r = 0; r < 2; ++r)
#pragma unroll
      for (int i = 0; i < 4; ++i) {
        const f32x4 t4 = __builtin_nontemporal_load((const f32x4*)(src + r * 1024) + lane + i * 64);
        v[r][i].x = t4[0]; v[r][i].y = t4[1]; v[r][i].z = t4[2]; v[r][i].w = t4[3];
      }
    float ss0 = 0.f, ss1 = 0.f;
#pragma unroll
    for (int i = 0; i < 4; ++i) {
      ss0 += v[0][i].x * v[0][i].x + v[0][i].y * v[0][i].y + v[0][i].z * v[0][i].z + v[0][i].w * v[0][i].w;
      ss1 += v[1][i].x * v[1][i].x + v[1][i].y * v[1][i].y + v[1][i].z * v[1][i].z + v[1][i].w * v[1][i].w;
    }
    ss0 = wave_sum(ss0);
    ss1 = wave_sum(ss1);
    const float r0 = rsqrtf(ss0 * (1.f / 1024.f) + 1e-6f), r1 = rsqrtf(ss1 * (1.f / 1024.f) + 1e-6f);
#pragma unroll
    for (int i = 0; i < 4; ++i) {
      float4 gn = ((const float4*)p.final_g)[lane + i * 64];
      float4 o0, o1;
      o0.x = v[0][i].x * r0 * gn.x; o0.y = v[0][i].y * r0 * gn.y; o0.z = v[0][i].z * r0 * gn.z; o0.w = v[0][i].w * r0 * gn.w;
      o1.x = v[1][i].x * r1 * gn.x; o1.y = v[1][i].y * r1 * gn.y; o1.z = v[1][i].z * r1 * gn.z; o1.w = v[1][i].w * r1 * gn.w;
      __builtin_nontemporal_store(f32x4{o0.x, o0.y, o0.z, o0.w}, (f32x4*)src + lane + i * 64);
      __builtin_nontemporal_store(f32x4{o1.x, o1.y, o1.z, o1.w}, (f32x4*)(src + 1024) + lane + i * 64);
    }
  }
}

extern "C" void kernel_launch(void* const* d_in, const int* in_sizes, int n_in, void* d_out, int out_size, void* d_ws,
                              size_t ws_size, hipStream_t stream) {
  static int grid_blocks = 0;
  if (grid_blocks == 0) {
    if (n_in != 20 || ws_size < (size_t)WS_END + 16384 || out_size != T * 1024) {
      fprintf(stderr, "kernel_launch: unexpected sizes n_in=%d ws=%zu out=%d (need ws >= %ld)\n", n_in, ws_size, out_size, (long)WS_END);
      grid_blocks = -1;
      return;
    }
    int dev = 0, cus = 0, per_cu = 0;
    hipGetDevice(&dev);
    hipDeviceGetAttribute(&cus, hipDeviceAttributeMultiprocessorCount, dev);
    hipFuncSetAttribute((const void*)mega, hipFuncAttributeMaxDynamicSharedMemorySize, LDS_BYTES);
    hipOccupancyMaxActiveBlocksPerMultiprocessor(&per_cu, (const void*)mega, 512, LDS_BYTES);
    if (per_cu < 1) per_cu = 1;
    if (per_cu > 1) per_cu = 1;
    grid_blocks = cus * per_cu;
    fprintf(stderr, "kernel_launch: cus=%d per_cu=%d grid=%d\n", cus, per_cu, grid_blocks);
  }
  if (grid_blocks < 0) return;
  Params p{};
  p.x = (const float*)d_in[0]; p.c = (const float*)d_in[1]; p.ctx = (const float*)d_in[2]; p.c_ctx = (const float*)d_in[3];
  p.w_ada = (const float*)d_in[4]; p.b_ada = (const float*)d_in[5]; p.norm1_g = (const float*)d_in[6]; p.w_in = (const float*)d_in[7];
  p.na_rpb = (const float*)d_in[8]; p.ldf = (const float*)d_in[9]; p.ldb = (const float*)d_in[10]; p.w_pna = (const float*)d_in[11];
  p.w_pret = (const float*)d_in[12]; p.w_out = (const float*)d_in[13]; p.norm2_g = (const float*)d_in[14]; p.w_up = (const float*)d_in[15];
  p.conv_w = (const float*)d_in[16]; p.conv_b = (const float*)d_in[17]; p.w_down = (const float*)d_in[18]; p.final_g = (const float*)d_in[19];
  p.out = (float*)d_out;
  p.ws = (char*)d_ws;
  void* args[] = {&p};
  hipError_t e = hipLaunchCooperativeKernel((const void*)mega, dim3(grid_blocks), dim3(512), args, LDS_BYTES, stream);
  if (e != hipSuccess) fprintf(stderr, "cooperative launch failed: %s (grid %d)\n", hipGetErrorString(e), grid_blocks);
}
```

```cpp
#include <hip/hip_runtime.h>
#include <hip/hip_cooperative_groups.h>
#include <cstdio>
namespace cg = cooperative_groups;

typedef unsigned short u16;
typedef __attribute__((ext_vector_type(8))) short bf16x8;
typedef __attribute__((ext_vector_type(4))) short bf16x4;
typedef __attribute__((ext_vector_type(4))) float f32x4;
typedef __attribute__((ext_vector_type(4))) unsigned int u32x4;
typedef __attribute__((ext_vector_type(2))) unsigned int u32x2;

constexpr int T = 32768, TC = 2048;
constexpr long SEG = 33554432L;

constexpr long OFF_WIN = 0;
constexpr long OFF_WPNA = 13631488L;
constexpr long OFF_WPRET = 14680064L;
constexpr long OFF_WOUT = 16777216L;
constexpr long OFF_WUP = 18874368L;
constexpr long OFF_WDOWN = 30408704L;
constexpr long OFF_MOD = 36175872L;
constexpr long OFF_ROPE = 36397056L;
constexpr long OFF_HX = 37748736L;
constexpr long OFF_Y = 109051904L;
constexpr long OFF_NAQ = OFF_Y;
constexpr long OFF_NAK = OFF_Y + SEG;
constexpr long OFF_NAVT = OFF_Y + 2 * SEG;
constexpr long OFF_RQ = OFF_Y + 3 * SEG;
constexpr long OFF_RK = OFF_Y + 4 * SEG;
constexpr long OFF_KTF = OFF_Y + 5 * SEG;
constexpr long OFF_KTB = OFF_Y + 6 * SEG;
constexpr long OFF_RVT = OFF_Y + 7 * SEG;
constexpr long OFF_RG = OFF_Y + 9 * SEG;
constexpr long OFF_CNAK = OFF_Y + 11 * SEG;
constexpr long OFF_CNAVT = OFF_CNAK + 2097152L;
constexpr long OFF_CKTF = OFF_CNAVT + 2097152L;
constexpr long OFF_CKTB = OFF_CKTF + 2097152L;
constexpr long OFF_CRVT = OFF_CKTB + 2097152L;
constexpr long WS_END = OFF_CRVT + 4194304L;
constexpr long OFF_MERGED = OFF_RVT;
constexpr long OFF_ORAW = OFF_KTF;
constexpr long OFF_PARK2 = OFF_RQ;
constexpr long OFF_HACTF = OFF_HX + (long)T * 2048;
constexpr long OFF_UH = OFF_HACTF + (long)T * 2816 * 2;
constexpr long OFF_HACT = OFF_HACTF;
static_assert(OFF_UH + (long)T * 3072 * 2 <= WS_END, "FFN scratch must fit the workspace map");

constexpr int HALF_LDS = 73728;
constexpr int PARAM_OFF = 2 * HALF_LDS;
constexpr int LDS_BYTES = PARAM_OFF + 256;

struct Params {
  const float *x, *c, *ctx, *c_ctx, *w_ada, *b_ada, *norm1_g, *w_in, *na_rpb, *ldf, *ldb, *w_pna, *w_pret, *w_out,
      *norm2_g, *w_up, *conv_w, *conv_b, *w_down, *final_g;
  float* out;
  char* ws;
};

typedef float f32x2_t __attribute__((ext_vector_type(2)));
typedef __bf16 bf16x2_t __attribute__((ext_vector_type(2)));
__device__ __forceinline__ unsigned pack2(float a, float b) {
  f32x2_t v = {a, b};
  bf16x2_t r = __builtin_convertvector(v, bf16x2_t);
  return __builtin_bit_cast(unsigned, r);
}
__device__ __forceinline__ u16 f2bf(float f) { return (u16)(pack2(f, 0.f) & 0xffffu); }
__device__ __forceinline__ float bf2f(u16 h) { return __uint_as_float(((unsigned)h) << 16); }
__device__ __forceinline__ u32x2 pack4(float a, float b, float c, float d) {
  u32x2 r = {pack2(a, b), pack2(c, d)}; return r;
}
__device__ __forceinline__ float sigmoidf_(float x) { return __builtin_amdgcn_rcpf(1.f + __expf(-x)); }
__device__ __forceinline__ float siluf_(float x) { return x * __builtin_amdgcn_rcpf(1.f + __expf(-x)); }

#define MFMA(a, b, c) __builtin_amdgcn_mfma_f32_16x16x32_bf16((a), (b), (c), 0, 0, 0)

__device__ __forceinline__ int lds_byte2(int r, int c) {
  int st = (r >> 4) * 2 + (c >> 5), ob = (r & 15) * 64 + (c & 31) * 2;
  return st * 1024 + (ob ^ (((ob >> 9) & 1) << 5));
}
__device__ __forceinline__ void stage_rc2(int b, int& R, int& C) {
  int st = b >> 10, sb = b & 1023, swz = sb ^ (((sb >> 9) & 1) << 5);
  R = (st >> 1) * 16 + swz / 64;
  C = (st & 1) * 32 + (swz % 64) / 2;
}
struct GA { const u16* A; const u16* B; int lda, ldb; };
template <bool SWAP>
__device__ __forceinline__ void gemm256(f32x4 (&acc)[8][4], const u16* __restrict__ A, long lda,
                                        const u16* __restrict__ B, long ldb, int K, char* shm, bool pre, GA nx) {
  constexpr int TILE_B = 256 * 64 * 2, STAGE_B = 2 * TILE_B;
  int tid = threadIdx.x;
  asm volatile("" : "+v"(tid));
  const int wid = tid >> 6, lane = tid & 63, wr = wid >> 2, wc = wid & 3, fr = lane & 15, fq = lane >> 4;
  unsigned offA[4], offB[4];
#pragma unroll
  for (int i = 0; i < 4; ++i) {
    int R, C;
    stage_rc2(wid * 1024 + i * 8192 + lane * 16, R, C);
    offA[i] = (unsigned)(R * (int)lda + C);
    offB[i] = (unsigned)(R * (int)ldb + C);
  }
#define G256_STAGE(buf, kt)                                                                                         \
  do {                                                                                                              \
    _Pragma("unroll") for (int i = 0; i < 4; ++i) {                                                                 \
      __builtin_amdgcn_global_load_lds((const unsigned*)(A + offA[i] + (kt) * 64),                                  \
                                       (__attribute__((address_space(3))) unsigned*)(shm + (buf) * STAGE_B + wid * 1024 + i * 8192), 16, 0, 0); \
      __builtin_amdgcn_global_load_lds((const unsigned*)(B + offB[i] + (kt) * 64),                                  \
                                       (__attribute__((address_space(3))) unsigned*)(shm + (buf) * STAGE_B + TILE_B + wid * 1024 + i * 8192), 16, 0, 0); \
    }                                                                                                               \
  } while (0)
  const int nt = K >> 6;
  if (!pre) G256_STAGE(0, 0);
  asm volatile("s_waitcnt vmcnt(0)" ::: "memory");
  __syncthreads();
  for (int t = 0; t < nt; ++t) {
    const int cur = t & 1;
    if (t + 1 < nt) G256_STAGE(cur ^ 1, t + 1);
    const char* sa = shm + cur * STAGE_B;
    const char* sb = sa + TILE_B;
#pragma unroll
    for (int ks = 0; ks < 2; ++ks) {
      bf16x8 Bf[4];
#pragma unroll
      for (int n = 0; n < 4; ++n) Bf[n] = *(const bf16x8*)(sb + lds_byte2(wc * 64 + n * 16 + fr, ks * 32 + fq * 8));
#pragma unroll
      for (int mh = 0; mh < 2; ++mh) {
        bf16x8 At[4];
#pragma unroll
        for (int m = 0; m < 4; ++m) At[m] = *(const bf16x8*)(sa + lds_byte2(wr * 128 + (mh * 4 + m) * 16 + fr, ks * 32 + fq * 8));
#pragma unroll
        for (int m = 0; m < 4; ++m)
#pragma unroll
          for (int n = 0; n < 4; ++n) {
            if (SWAP) acc[mh * 4 + m][n] = MFMA(Bf[n], At[m], acc[mh * 4 + m][n]);
            else acc[mh * 4 + m][n] = MFMA(At[m], Bf[n], acc[mh * 4 + m][n]);
          }
      }
      __builtin_amdgcn_sched_group_barrier(0x100, 8, 0);
      __builtin_amdgcn_sched_group_barrier(0x008, 4, 0);
      __builtin_amdgcn_sched_group_barrier(0x100, 1, 0);
      __builtin_amdgcn_sched_group_barrier(0x008, 4, 0);
      __builtin_amdgcn_sched_group_barrier(0x100, 1, 0);
      __builtin_amdgcn_sched_group_barrier(0x008, 4, 0);
      __builtin_amdgcn_sched_group_barrier(0x100, 1, 0);
      __builtin_amdgcn_sched_group_barrier(0x008, 4, 0);
      __builtin_amdgcn_sched_group_barrier(0x100, 1, 0);
      __builtin_amdgcn_sched_group_barrier(0x008, 16, 0);
      __builtin_amdgcn_sched_barrier(0);
    }
    asm volatile("s_waitcnt vmcnt(0)" ::: "memory");
    __syncthreads();
  }
#undef G256_STAGE
  if (nx.A != nullptr) {
#pragma unroll
    for (int i = 0; i < 4; ++i) {
      int R, C;
      stage_rc2(wid * 1024 + i * 8192 + lane * 16, R, C);
      __builtin_amdgcn_global_load_lds((const unsigned*)(nx.A + (unsigned)(R * nx.lda + C)),
                                       (__attribute__((address_space(3))) unsigned*)(shm + wid * 1024 + i * 8192), 16, 0, 0);
      __builtin_amdgcn_global_load_lds((const unsigned*)(nx.B + (unsigned)(R * nx.ldb + C)),
                                       (__attribute__((address_space(3))) unsigned*)(shm + TILE_B + wid * 1024 + i * 8192), 16, 0, 0);
    }
  }
}

__device__ __forceinline__ void zero_acc(f32x4 (&acc)[8][4]) {
#pragma unroll
  for (int i = 0; i < 8; ++i)
#pragma unroll
    for (int j = 0; j < 4; ++j) acc[i][j] = f32x4{0.f, 0.f, 0.f, 0.f};
}

#define EPI_IDS int tid = threadIdx.x; asm volatile("" : "+v"(tid)); const int wid = tid >> 6, lane = tid & 63, wr = wid >> 2, wc = wid & 3, fr = lane & 15, fq = lane >> 4
__device__ __forceinline__ void tile_mn(int id, int NT, int& mt, int& nt) {
  const int G = 16;
  int grp = id / (G * NT), rem = id % (G * NT);
  nt = rem / G;
  mt = grp * G + (rem % G);
}

__device__ __forceinline__ void p0_transpose(const float* __restrict__ src, int K, int N, u16* __restrict__ dst, int tile, float* lds, int tid) {
  const int nk = K >> 6;
  const int tk = tile % nk, tn = tile / nk;
  const int k0 = tk * 64, n0 = tn * 64;
  {
    const int r0 = tid >> 4, c = (tid & 15) * 4;
    float4 v0 = *(const float4*)(src + (long)(k0 + r0) * N + n0 + c);
    float4 v1 = *(const float4*)(src + (long)(k0 + r0 + 16) * N + n0 + c);
    float4 v2 = *(const float4*)(src + (long)(k0 + r0 + 32) * N + n0 + c);
    float4 v3 = *(const float4*)(src + (long)(k0 + r0 + 48) * N + n0 + c);
    float* l0 = lds + r0 * 65 + c;
    l0[0] = v0.x; l0[1] = v0.y; l0[2] = v0.z; l0[3] = v0.w;
    l0[16 * 65 + 0] = v1.x; l0[16 * 65 + 1] = v1.y; l0[16 * 65 + 2] = v1.z; l0[16 * 65 + 3] = v1.w;
    l0[32 * 65 + 0] = v2.x; l0[32 * 65 + 1] = v2.y; l0[32 * 65 + 2] = v2.z; l0[32 * 65 + 3] = v2.w;
    l0[48 * 65 + 0] = v3.x; l0[48 * 65 + 1] = v3.y; l0[48 * 65 + 2] = v3.z; l0[48 * 65 + 3] = v3.w;
  }
  __syncthreads();
#pragma unroll 4
  for (int i = 0; i < 8; ++i) {
    int idx = tid + i * 256;
    int n = idx >> 5, kp = idx & 31;
    unsigned v = pack2(lds[(2 * kp) * 65 + n], lds[(2 * kp + 1) * 65 + n]);
    *(unsigned*)(dst + (long)(n0 + n) * K + k0 + 2 * kp) = v;
  }
  __syncthreads();
}

__device__ __forceinline__ void p0_adaln(const Params& p, int u, float* sl, int tid) {
  const int col0 = u * 32;
  for (int i = tid; i < 9 * 1024; i += 256) {
    int r = i >> 10, k = i & 1023;
    float v = (r < 8) ? p.c[r * 1024 + k] : p.c_ctx[k];
    sl[i] = v / (1.f + expf(-v));
  }
  __syncthreads();
  const int col = tid & 31, kg = tid >> 5;
  float acc[9];
#pragma unroll
  for (int r = 0; r < 9; ++r) acc[r] = 0.f;
#pragma unroll 4
  for (int k = kg * 128; k < kg * 128 + 128; ++k) {
    float wv = p.w_ada[(long)k * 6144 + col0 + col];
#pragma unroll
    for (int r = 0; r < 9; ++r) acc[r] += sl[r * 1024 + k] * wv;
  }
  float* red = sl + 9216;
#pragma unroll
  for (int r = 0; r < 9; ++r) red[(kg * 9 + r) * 32 + col] = acc[r];
  __syncthreads();
  for (int i = tid; i < 288; i += 256) {
    int r = i >> 5, cc = i & 31;
    float s = 0.f;
#pragma unroll
    for (int k2 = 0; k2 < 8; ++k2) s += red[(k2 * 9 + r) * 32 + cc];
    float* mod = (float*)(p.ws + OFF_MOD);
    mod[r * 6144 + col0 + cc] = s + p.b_ada[col0 + cc];
  }
  __syncthreads();
}

__device__ __forceinline__ void my_sincos(double x, double* s, double* c) {
  double kd = rint(x * 0.63661977236758134308);
  int k = (int)kd;
  double r = x - kd * 1.5707963267948966192;
  r -= kd * 6.123233995736766e-17;
  double r2 = r * r;
  double sp = r * (1.0 + r2 * (-1.0 / 6.0 + r2 * (1.0 / 120.0 + r2 * (-1.0 / 5040.0 + r2 * (1.0 / 362880.0 + r2 * (-1.0 / 39916800.0 + r2 * (1.0 / 6227020800.0 + r2 * (-1.0 / 1307674368000.0))))))));
  double cp = 1.0 + r2 * (-0.5 + r2 * (1.0 / 24.0 + r2 * (-1.0 / 720.0 + r2 * (1.0 / 40320.0 + r2 * (-1.0 / 3628800.0 + r2 * (1.0 / 479001600.0 + r2 * (-1.0 / 87178291200.0 + r2 * (1.0 / 20922789888000.0))))))));
  int q = k & 3;
  if (q == 0) { *s = sp; *c = cp; }
  else if (q == 1) { *s = cp; *c = -sp; }
  else if (q == 2) { *s = -sp; *c = -cp; }
  else { *s = -cp; *c = sp; }
}

__device__ __forceinline__ void p0_rope(const Params& p, int tid) {
  float* tab = (float*)(p.ws + OFF_ROPE);
  for (int e = tid * 8; e < tid * 8 + 8; ++e) {
    int pos = e >> 5, i = e & 31;
    double inv = exp(-(double)i * (9.210340371976184 / 32.0));
    float invf = (float)inv;
    float ang = (float)pos * invf;
    double s, c;
    my_sincos((double)ang, &s, &c);
    tab[e * 2] = (float)c;
    tab[e * 2 + 1] = (float)s;
  }
}

__device__ __forceinline__ void p0_unit(const Params& p, int u, char* smem, int tid) {
  float* lds = (float*)smem;
  if (u < 1664) { p0_transpose(p.w_in, 1024, 6656, (u16*)(p.ws + OFF_WIN), u, lds, tid); return; }
  u -= 1664;
  if (u < 128) { p0_transpose(p.w_pna, 512, 1024, (u16*)(p.ws + OFF_WPNA), u, lds, tid); return; }
  u -= 128;
  if (u < 256) { p0_transpose(p.w_pret, 1024, 1024, (u16*)(p.ws + OFF_WPRET), u, lds, tid); return; }
  u -= 256;
  if (u < 256) { p0_transpose(p.w_out, 1024, 1024, (u16*)(p.ws + OFF_WOUT), u, lds, tid); return; }
  u -= 256;
  if (u < 1408) { p0_transpose(p.w_up, 1024, 5632, (u16*)(p.ws + OFF_WUP), u, lds, tid); return; }
  u -= 1408;
  if (u < 704) { p0_transpose(p.w_down, 2816, 1024, (u16*)(p.ws + OFF_WDOWN), u, lds, tid); return; }
  u -= 704;
  if (u < 192) { p0_adaln(p, u, lds, tid); return; }
  p0_rope(p, tid);
}
constexpr int P0_UNITS = 1664 + 128 + 256 + 256 + 1408 + 704 + 192 + 1;

__device__ __forceinline__ float wave_sum(float v) {
#pragma unroll
  for (int o = 32; o >= 1; o >>= 1) v += __shfl_xor(v, o);
  return v;
}

__device__ __forceinline__ void rownorm2_bf16(const float* __restrict__ src, const float* __restrict__ gain,
                                              const float* __restrict__ shift, const float* __restrict__ scale,
                                              u16* __restrict__ dst) {
  const int lane = threadIdx.x & 63;
  float4 v[2][4];
#pragma unroll
  for (int r = 0; r < 2; ++r)
#pragma unroll
    for (int i = 0; i < 4; ++i) {
      const f32x4 t4 = __builtin_nontemporal_load((const f32x4*)(src + r * 1024) + lane + i * 64);
      v[r][i].x = t4[0]; v[r][i].y = t4[1]; v[r][i].z = t4[2]; v[r][i].w = t4[3];
    }
  float ss0 = 0.f, ss1 = 0.f;
#pragma unroll
  for (int i = 0; i < 4; ++i) {
    ss0 += v[0][i].x * v[0][i].x + v[0][i].y * v[0][i].y + v[0][i].z * v[0][i].z + v[0][i].w * v[0][i].w;
    ss1 += v[1][i].x * v[1][i].x + v[1][i].y * v[1][i].y + v[1][i].z * v[1][i].z + v[1][i].w * v[1][i].w;
  }
  ss0 = wave_sum(ss0);
  ss1 = wave_sum(ss1);
  const float r0 = rsqrtf(ss0 * (1.f / 1024.f) + 1e-6f), r1 = rsqrtf(ss1 * (1.f / 1024.f) + 1e-6f);
#pragma unroll
  for (int i = 0; i < 4; ++i) {
    const int c4 = lane + i * 64;
    float4 gn = ((const float4*)gain)[c4];
    float4 sh = ((const float4*)shift)[c4];
    float4 sc = ((const float4*)scale)[c4];
    *(u32x2*)(dst + c4 * 4) = pack4((v[0][i].x * r0 * gn.x) * (1.f + sc.x) + sh.x, (v[0][i].y * r0 * gn.y) * (1.f + sc.y) + sh.y,
                                    (v[0][i].z * r0 * gn.z) * (1.f + sc.z) + sh.z, (v[0][i].w * r0 * gn.w) * (1.f + sc.w) + sh.w);
    *(u32x2*)(dst + 1024 + c4 * 4) = pack4((v[1][i].x * r1 * gn.x) * (1.f + sc.x) + sh.x, (v[1][i].y * r1 * gn.y) * (1.f + sc.y) + sh.y,
                                           (v[1][i].z * r1 * gn.z) * (1.f + sc.z) + sh.z, (v[1][i].w * r1 * gn.w) * (1.f + sc.w) + sh.w);
  }
}


constexpr int WST_OFF = 65536;
constexpr int WST_BYTES = 9216;
constexpr int ZTAB_OFF = WST_OFF + 8 * WST_BYTES;

__device__ __forceinline__ void wave_store_nat_bf16(const f32x4 (&acc)[8][4], char* smem, u16* dst, long ld, float mul,
                                                    int wid, int lane, int fr, int fq) {
  u16* st = (u16*)(smem + WST_OFF + wid * WST_BYTES);
#pragma unroll
  for (int ps = 0; ps < 2; ++ps) {
#pragma unroll
    for (int m4 = 0; m4 < 4; ++m4)
#pragma unroll
      for (int n = 0; n < 4; ++n)
        *(u32x2*)(st + (m4 * 16 + fr) * 72 + n * 16 + fq * 4) =
            pack4(acc[ps * 4 + m4][n][0] * mul, acc[ps * 4 + m4][n][1] * mul, acc[ps * 4 + m4][n][2] * mul, acc[ps * 4 + m4][n][3] * mul);
#pragma unroll
    for (int i = 0; i < 8; ++i) {
      int id = lane + i * 64;
      int rl = id >> 3, c8 = (id & 7) * 8;
      __builtin_nontemporal_store(*(const u32x4*)(st + rl * 72 + c8), (u32x4*)(dst + (long)(ps * 64 + rl) * ld + c8));
    }
  }
}
__device__ __forceinline__ void wave_stage_tr(const f32x4 (&acc)[8][4], u16* st, int ps, float mul, int fr, int fq) {
#pragma unroll
  for (int nl = 0; nl < 2; ++nl)
#pragma unroll
    for (int m = 0; m < 8; ++m)
      *(u32x2*)(st + (nl * 16 + fr) * 136 + m * 16 + fq * 4) =
          pack4(acc[m][ps * 2 + nl][0] * mul, acc[m][ps * 2 + nl][1] * mul, acc[m][ps * 2 + nl][2] * mul, acc[m][ps * 2 + nl][3] * mul);
}
__device__ __forceinline__ void wave_store_tr_bf16(const f32x4 (&acc)[8][4], char* smem, u16* dstT, long tstride,
                                                   int wid, int lane, int fr, int fq) {
  u16* st = (u16*)(smem + WST_OFF + wid * WST_BYTES);
#pragma unroll
  for (int ps = 0; ps < 2; ++ps) {
    wave_stage_tr(acc, st, ps, 1.f, fr, fq);
#pragma unroll
    for (int i = 0; i < 8; ++i) {
      int id = lane + i * 64;
      int cl = id >> 4, r8 = (id & 15) * 8;
      __builtin_nontemporal_store(*(const u32x4*)(st + cl * 136 + r8), (u32x4*)(dstT + (long)(ps * 32 + cl) * tstride + r8));
    }
  }
}

template <int KIND>
__device__ __forceinline__ void inproj_kind(const Params& p, bool isctx, int m0, int nt256, char* smem, bool pre, GA nx) {
  const u16* A = (const u16*)(p.ws + OFF_HX) + (long)((isctx ? T : 0) + m0) * 1024;
  const u16* Bt = (const u16*)(p.ws + OFF_WIN) + (long)nt256 * 256 * 1024;
  const int seg = nt256 >> 1;
  const float2* rope = (const float2*)(p.ws + OFF_ROPE);
  f32x4 acc[8][4];
  zero_acc(acc);
  if (KIND == 0 || KIND == 1) {
    gemm256<true>(acc, A, 1024, Bt, 1024, 1024, smem, pre, nx);
    EPI_IDS;
    if (KIND == 1) {
#pragma unroll
      for (int m = 0; m < 8; ++m) {
        int n_ = (m0 + wr * 128 + m * 16 + fr) & 4095;
        int pos = ((wc & 1) == 0) ? (n_ >> 6) : (n_ & 63);
        const float2* rp = rope + pos * 32 + fq * 4;
#pragma unroll
        for (int nt = 0; nt < 2; ++nt) {
          float4 c01 = *(const float4*)(rp + nt * 16);
          float4 c23 = *(const float4*)(rp + nt * 16 + 2);
          float cs_[4] = {c01.x, c01.z, c23.x, c23.z}, sn_[4] = {c01.y, c01.w, c23.y, c23.w};
#pragma unroll
          for (int j = 0; j < 4; ++j) {
            float lo = acc[m][nt][j], hi = acc[m][nt + 2][j];
            acc[m][nt][j] = lo * cs_[j] - hi * sn_[j];
            acc[m][nt + 2][j] = lo * sn_[j] + hi * cs_[j];
          }
        }
      }
    }
    u16* dst; int ld; int cbase; float mul = 1.f;
    if (KIND == 1) { dst = (u16*)(p.ws + OFF_RQ); ld = 512; cbase = nt256 * 256 - 1536; }
    else if (seg == 0) { dst = (u16*)(p.ws + OFF_NAQ); ld = 512; cbase = nt256 * 256; mul = 0.125f; }
    else if (seg == 1) { dst = isctx ? (u16*)(p.ws + OFF_CNAK) : (u16*)(p.ws + OFF_NAK); ld = 512; cbase = nt256 * 256 - 512; }
    else { dst = (u16*)(p.ws + OFF_RG); ld = 1024; cbase = nt256 * 256 - 3584; }
    wave_store_nat_bf16(acc, smem, dst + (long)(m0 + wr * 128) * ld + cbase + wc * 64, ld, mul, wid, lane, fr, fq);
  } else {
    if (KIND == 3) {
      float* ztw = (float*)(smem + ZTAB_OFF);
      const int t_ = threadIdx.x;
      __syncthreads();
      if (t_ < 256) {
        int hh = (nt256 & 1) * 2 + (t_ >> 7), mm = t_ & 127;
        ztw[t_] = expf(p.ldf[hh] * (float)(127 - mm));
        ztw[256 + t_] = expf(p.ldb[hh] * (float)mm);
      }
    }
    gemm256<false>(acc, A, 1024, Bt, 1024, 1024, smem, pre, nx);
    EPI_IDS;
    const int bb = isctx ? (m0 >> 8) : (m0 >> 12);
    const int nbase = isctx ? 0 : (m0 & 4095);
    const long tstride = isctx ? 256 : 4096;
    if (KIND == 2) {
      u16* dst; int cg0; long bstride;
      if (seg == 2) { dst = isctx ? (u16*)(p.ws + OFF_CNAVT) : (u16*)(p.ws + OFF_NAVT); cg0 = nt256 * 256 - 1024; bstride = 512; }
      else { dst = isctx ? (u16*)(p.ws + OFF_CRVT) : (u16*)(p.ws + OFF_RVT); cg0 = nt256 * 256 - 2560; bstride = 1024; }
      wave_store_tr_bf16(acc, smem, dst + ((long)bb * bstride + cg0 + wc * 64) * tstride + nbase + wr * 128, tstride, wid, lane, fr, fq);
    } else {
      const int h = (nt256 & 1) * 2 + (wc >> 1);
      const float rks = 0.08838834764831845f;
      const float* ztab = (const float*)(smem + ZTAB_OFF);
      if (!isctx) {
#pragma unroll
        for (int m = 0; m < 8; ++m) {
#pragma unroll
          for (int j = 0; j < 4; ++j) {
            int n_ = (m0 + wr * 128 + m * 16 + fq * 4 + j) & 4095;
            int pos = ((wc & 1) == 0) ? (n_ >> 6) : (n_ & 63);
#pragma unroll
            for (int nt = 0; nt < 2; ++nt) {
              float2 cs = rope[pos * 32 + nt * 16 + fr];
              float lo = acc[m][nt][j], hi = acc[m][nt + 2][j];
              acc[m][nt][j] = lo * cs.x - hi * cs.y;
              acc[m][nt + 2][j] = lo * cs.y + hi * cs.x;
            }
          }
        }
      }
      u16* rk = (u16*)(p.ws + OFF_RK);
      u16* ktf = isctx ? (u16*)(p.ws + OFF_CKTF) : (u16*)(p.ws + OFF_KTF);
      u16* ktb = isctx ? (u16*)(p.ws + OFF_CKTB) : (u16*)(p.ws + OFF_KTB);
      u16* st = (u16*)(smem + WST_OFF + wid * WST_BYTES);
      const float* zfh = ztab + (wc >> 1) * 128;
      const float* zbh = ztab + 256 + (wc >> 1) * 128;
      const int dkb = (wc & 1) * 64;
#pragma unroll
      for (int ps = 0; ps < 2; ++ps) {
        wave_stage_tr(acc, st, ps, rks, fr, fq);
#pragma unroll
        for (int i = 0; i < 8; ++i) {
          int id = lane + i * 64;
          int cl = id >> 4, r8 = (id & 15) * 8;
          u32x4 v = *(const u32x4*)(st + cl * 136 + r8);
          float4 zf0 = *(const float4*)(zfh + r8), zf1 = *(const float4*)(zfh + r8 + 4);
          float4 zb0 = *(const float4*)(zbh + r8), zb1 = *(const float4*)(zbh + r8 + 4);
          float e0 = bf2f((u16)(v[0] & 0xffffu)), e1 = bf2f((u16)(v[0] >> 16)), e2 = bf2f((u16)(v[1] & 0xffffu)), e3 = bf2f((u16)(v[1] >> 16));
          float e4 = bf2f((u16)(v[2] & 0xffffu)), e5 = bf2f((u16)(v[2] >> 16)), e6 = bf2f((u16)(v[3] & 0xffffu)), e7 = bf2f((u16)(v[3] >> 16));
          long tb = ((long)(bb * 4 + h) * 128 + dkb + ps * 32 + cl) * tstride + nbase + wr * 128 + r8;
          u32x4 of = {pack2(e0 * zf0.x, e1 * zf0.y), pack2(e2 * zf0.z, e3 * zf0.w), pack2(e4 * zf1.x, e5 * zf1.y), pack2(e6 * zf1.z, e7 * zf1.w)};
          u32x4 ob = {pack2(e0 * zb0.x, e1 * zb0.y), pack2(e2 * zb0.z, e3 * zb0.w), pack2(e4 * zb1.x, e5 * zb1.y), pack2(e6 * zb1.z, e7 * zb1.w)};
          *(u32x4*)(ktf + tb) = of;
          *(u32x4*)(ktb + tb) = ob;
        }
        if (!isctx) {
#pragma unroll
          for (int i = 0; i < 8; ++i) {
            int id = lane + i * 64;
            int row = id >> 2, c8 = (id & 3) * 8;
            const u16* sp = st + c8 * 136 + row;
            u32x4 o = {(unsigned)sp[0] | ((unsigned)sp[136] << 16), (unsigned)sp[2 * 136] | ((unsigned)sp[3 * 136] << 16),
                       (unsigned)sp[4 * 136] | ((unsigned)sp[5 * 136] << 16), (unsigned)sp[6 * 136] | ((unsigned)sp[7 * 136] << 16)};
            *(u32x4*)(rk + (long)(m0 + wr * 128 + row) * 512 + h * 128 + dkb + ps * 32 + c8) = o;
          }
        }
      }
    }
  }
}

__device__ __forceinline__ void inproj_decode(int id, bool& isctx, int& m0, int& nt256) {
  int mt_;
  if (id < 2304) { isctx = false; tile_mn(id, 18, mt_, nt256); }
  else {
    isctx = true;
    int id2 = id - 2304;
    mt_ = id2 & 7;
    int j = id2 >> 3;
    nt256 = (j < 4) ? (2 + j) : ((j < 6) ? (8 + (j - 4)) : (10 + (j - 6)));
  }
  m0 = mt_ * 256;
}
__device__ __forceinline__ GA inproj_ga(const Params& p, int id) {
  GA g; g.A = nullptr; g.B = nullptr; g.lda = 1024; g.ldb = 1024;
  if (id < 2304 + 80) {
    bool isctx; int m0, nt256;
    inproj_decode(id, isctx, m0, nt256);
    g.A = (const u16*)(p.ws + OFF_HX) + (long)((isctx ? T : 0) + m0) * 1024;
    g.B = (const u16*)(p.ws + OFF_WIN) + (long)nt256 * 256 * 1024;
  }
  return g;
}
__device__ __forceinline__ void inproj_tile(const Params& p, int id, char* smem, bool pre, GA nx) {
  bool isctx;
  int m0, nt256;
  inproj_decode(id, isctx, m0, nt256);
  const int seg = nt256 >> 1;
  if (seg == 3) inproj_kind<1>(p, isctx, m0, nt256, smem, pre, nx);
  else if (seg == 4) inproj_kind<3>(p, isctx, m0, nt256, smem, pre, nx);
  else if (seg == 2 || seg == 5 || seg == 6) inproj_kind<2>(p, isctx, m0, nt256, smem, pre, nx);
  else inproj_kind<0>(p, isctx, m0, nt256, smem, pre, nx);
}

struct NaRegs { u32x4 k0, k1, k2, k3, v0, v1, v2, v3, q0, q1; };

__device__ __forceinline__ void na_issue(const Params& p, int u, int chunk, int tid, NaRegs& R) {
  const int r = u & 63, head = (u >> 6) & 7, b = u >> 9;
  const int rs = min(max(r - 4, 0), 56);
  const int krow = tid >> 3, kcc = (tid & 7) * 8;
  const int vrow = tid >> 4, vcc = (tid & 15) * 8;
  const u16* kb; long ks_; const u16* vb; long vs_;
  if (chunk < 4) {
    kb = (const u16*)(p.ws + OFF_NAK) + (long)(b * 4096 + rs * 64 + chunk * 128 + krow) * 512 + head * 64 + kcc; ks_ = 32L * 512;
    vb = (const u16*)(p.ws + OFF_NAVT) + ((long)((b * 8 + head) * 64 + vrow)) * 4096 + rs * 64 + chunk * 128 + vcc; vs_ = 16L * 4096;
  } else {
    kb = (const u16*)(p.ws + OFF_CNAK) + (long)(b * 256 + (chunk - 4) * 128 + krow) * 512 + head * 64 + kcc; ks_ = 32L * 512;
    vb = (const u16*)(p.ws + OFF_CNAVT) + ((long)((b * 8 + head) * 64 + vrow)) * 256 + (chunk - 4) * 128 + vcc; vs_ = 16L * 256;
  }
  R.k0 = *(const u32x4*)(kb); R.k1 = *(const u32x4*)(kb + ks_); R.k2 = *(const u32x4*)(kb + 2 * ks_); R.k3 = *(const u32x4*)(kb + 3 * ks_);
  R.v0 = *(const u32x4*)(vb); R.v1 = *(const u32x4*)(vb + vs_); R.v2 = *(const u32x4*)(vb + 2 * vs_); R.v3 = *(const u32x4*)(vb + 3 * vs_);
  if (chunk == 0) {
    const u16* qb = (const u16*)(p.ws + OFF_NAQ) + (long)(b * 4096 + r * 64 + krow) * 512 + head * 64 + kcc;
    R.q0 = *(const u32x4*)(qb);
    R.q1 = *(const u32x4*)(qb + 32L * 512);
  }
}

__device__ __forceinline__ void na_run(const Params& p, int first, int stride, int count, char* smem, int tid) {
  u16* Qs = (u16*)smem;
  u16* Ks = Qs + 64 * 72;
  u16* Vt = Ks + 128 * 72;
  float* bias = (float*)(Vt + 64 * 136);
  const int lane = tid & 63, w = tid >> 6, l15 = lane & 15, g = lane >> 4;
  const int krow = tid >> 3, kcc = (tid & 7) * 8, vrow = tid >> 4, vcc = (tid & 15) * 8;
  const int qc = w * 16 + l15;
  const int cs = min(max(qc - 8, 0), 48);
  const int cw = min(max(16 * w - 8, 0), 32);
  int dco[2][4];
  unsigned okm = 0u;
#pragma unroll
  for (int tt = 0; tt < 2; ++tt)
#pragma unroll
    for (int j = 0; j < 4; ++j) {
      int kc = cw + tt * 16 + g * 4 + j;
      if ((kc >= cs) && (kc < cs + 16)) okm |= 1u << (tt * 4 + j);
      dco[tt][j] = min(max(kc - qc + 15, 0), 30);
    }
  NaRegs R;
  if (count > 0) na_issue(p, first, 0, tid, R);
  for (int k = 0; k < count; ++k) {
    const int u = first + k * stride;
    const int r = u & 63, head = (u >> 6) & 7, b = u >> 9;
    const int rs = min(max(r - 4, 0), 56);
    f32x4 O[4];
#pragma unroll
    for (int i = 0; i < 4; ++i) O[i] = f32x4{0.f, 0.f, 0.f, 0.f};
    float m_run = -1e30f, l_run = 0.f;
    bf16x8 qf[2];
    for (int chunk = 0; chunk < 6; ++chunk) {
      __syncthreads();
      *(u32x4*)(Ks + krow * 72 + kcc) = R.k0; *(u32x4*)(Ks + (krow + 32) * 72 + kcc) = R.k1;
      *(u32x4*)(Ks + (krow + 64) * 72 + kcc) = R.k2; *(u32x4*)(Ks + (krow + 96) * 72 + kcc) = R.k3;
      *(u32x4*)(Vt + vrow * 136 + vcc) = R.v0; *(u32x4*)(Vt + (vrow + 16) * 136 + vcc) = R.v1;
      *(u32x4*)(Vt + (vrow + 32) * 136 + vcc) = R.v2; *(u32x4*)(Vt + (vrow + 48) * 136 + vcc) = R.v3;
      if (chunk == 0) {
        *(u32x4*)(Qs + krow * 72 + kcc) = R.q0; *(u32x4*)(Qs + (krow + 32) * 72 + kcc) = R.q1;
        for (int i = tid; i < 465; i += 256) bias[i] = p.na_rpb[head * 465 + i];
      }
      __syncthreads();
      if (chunk < 5) na_issue(p, u, chunk + 1, tid, R);
      else if (k + 1 < count) na_issue(p, u + stride, 0, tid, R);
      if (chunk == 0) {
        qf[0] = *(const bf16x8*)(Qs + (w * 16 + l15) * 72 + g * 8);
        qf[1] = *(const bf16x8*)(Qs + (w * 16 + l15) * 72 + 32 + g * 8);
      }
#pragma unroll
      for (int kg = 0; kg < 4; ++kg) {
        if (chunk < 4 && kg >= 2) continue;
        const int kb = (chunk < 4) ? (kg * 64 + cw) : (kg * 32);
        const int boff = (rs - r + 7 + chunk * 2 + kg) * 31;
        f32x4 s[2];
#pragma unroll
        for (int tt = 0; tt < 2; ++tt) {
          s[tt] = f32x4{0.f, 0.f, 0.f, 0.f};
#pragma unroll
          for (int ks = 0; ks < 2; ++ks) {
            bf16x8 a = *(const bf16x8*)(Ks + (kb + tt * 16 + l15) * 72 + ks * 32 + g * 8);
            s[tt] = MFMA(a, qf[ks], s[tt]);
          }
        }
        float mx = -1e30f;
#pragma unroll
        for (int tt = 0; tt < 2; ++tt)
#pragma unroll
          for (int j = 0; j < 4; ++j) {
            float v = s[tt][j];
            if (chunk < 4) {
              const bool ok = (okm >> (tt * 4 + j)) & 1u;
              v = ok ? (v + bias[boff + dco[tt][j]]) : -1e30f;
            }
            s[tt][j] = v;
            mx = fmaxf(mx, v);
          }
        mx = fmaxf(mx, __shfl_xor(mx, 16));
        mx = fmaxf(mx, __shfl_xor(mx, 32));
        const float m_new = fmaxf(m_run, mx);
        const float sc = __expf(m_run - m_new);
        m_run = m_new;
        float ps = 0.f;
#pragma unroll
        for (int tt = 0; tt < 2; ++tt)
#pragma unroll
          for (int j = 0; j < 4; ++j) {
            float v = s[tt][j];
            float pv = (v > -1e29f) ? __expf(v - m_new) : 0.f;
            s[tt][j] = pv;
            ps += pv;
          }
        l_run = l_run * sc + ps;
#pragma unroll
        for (int mt = 0; mt < 4; ++mt) O[mt] *= sc;
        u32x2 p0 = pack4(s[0][0], s[0][1], s[0][2], s[0][3]);
        u32x2 p1 = pack4(s[1][0], s[1][1], s[1][2], s[1][3]);
        u32x4 pb = {p0.x, p0.y, p1.x, p1.y};
        bf16x8 bfr = __builtin_bit_cast(bf16x8, pb);
#pragma unroll
        for (int mt = 0; mt < 4; ++mt) {
          const u16* vp = Vt + (mt * 16 + l15) * 136 + kb + g * 4;
          u32x2 a0 = *(const u32x2*)vp;
          u32x2 a1 = *(const u32x2*)(vp + 16);
          u32x4 ab = {a0.x, a0.y, a1.x, a1.y};
          O[mt] = MFMA(__builtin_bit_cast(bf16x8, ab), bfr, O[mt]);
        }
      }
    }
    l_run += __shfl_xor(l_run, 16);
    l_run += __shfl_xor(l_run, 32);
    const float inv = 1.f / l_run;
    u16* o = (u16*)(p.ws + OFF_NAQ) + (long)(b * 4096 + r * 64 + qc) * 512 + head * 64 + g * 4;
#pragma unroll
    for (int mt = 0; mt < 4; ++mt)
      *(u32x2*)(o + mt * 16) = pack4(O[mt][0] * inv, O[mt][1] * inv, O[mt][2] * inv, O[mt][3] * inv);
  }
}

struct ScanRegs { u32x4 k0, k1, k2, k3, k4, k5, k6, k7, v0, v1, v2, v3; };

__device__ __forceinline__ void scan_issue(const Params& p, int b, int h, int dir, int s, int step, int tid, ScanRegs& R) {
  const bool isctx = step < 2;
  const int c = isctx ? (dir ? 1 - step : step) : (dir ? 31 - (step - 2) : step - 2);
  const int row = tid >> 4, cc = (tid & 15) * 8;
  const u16* kb; const u16* vb; long st;
  if (isctx) {
    kb = (const u16*)(p.ws + (dir ? OFF_CKTB : OFF_CKTF)) + ((long)((b * 4 + h) * 128 + row)) * 256 + c * 128 + cc;
    vb = (const u16*)(p.ws + OFF_CRVT) + ((long)((b * 4 + h) * 256 + s * 64 + row)) * 256 + c * 128 + cc;
    st = 16L * 256;
  } else {
    kb = (const u16*)(p.ws + (dir ? OFF_KTB : OFF_KTF)) + ((long)((b * 4 + h) * 128 + row)) * 4096 + c * 128 + cc;
    vb = (const u16*)(p.ws + OFF_RVT) + ((long)((b * 4 + h) * 256 + s * 64 + row)) * 4096 + c * 128 + cc;
    st = 16L * 4096;
  }
  R.k0 = *(const u32x4*)(kb); R.k1 = *(const u32x4*)(kb + st); R.k2 = *(const u32x4*)(kb + 2 * st); R.k3 = *(const u32x4*)(kb + 3 * st);
  R.k4 = *(const u32x4*)(kb + 4 * st); R.k5 = *(const u32x4*)(kb + 5 * st); R.k6 = *(const u32x4*)(kb + 6 * st); R.k7 = *(const u32x4*)(kb + 7 * st);
  R.v0 = *(const u32x4*)(vb); R.v1 = *(const u32x4*)(vb + st); R.v2 = *(const u32x4*)(vb + 2 * st); R.v3 = *(const u32x4*)(vb + 3 * st);
}

__device__ __forceinline__ void scan_step(const Params& p, ScanRegs& R, f32x4 (&S)[8], int b, int h, int dir, int s, int step,
                                          float gL, u16* Kt, u16* Vs, int tid) {
  const int lane = tid & 63, w = tid >> 6, l15 = lane & 15, g = lane >> 4;
  const int row = tid >> 4, cc = (tid & 15) * 8;
  const bool isctx = step < 2;
  const int c = isctx ? (dir ? 1 - step : step) : (dir ? 31 - (step - 2) : step - 2);
  if (!isctx) {
    u16* dst = (u16*)p.out + ((((long)(b * 4 + h) * 32 + c) * 2 + dir) * 32768L) + (long)(s * 64 + w * 16 + l15) * 128 + g * 4;
#pragma unroll
    for (int i = 0; i < 8; ++i) *(u32x2*)(dst + i * 16) = pack4(S[i][0], S[i][1], S[i][2], S[i][3]);
  }
  *(u32x4*)(Kt + row * 136 + cc) = R.k0; *(u32x4*)(Kt + (row + 16) * 136 + cc) = R.k1;
  *(u32x4*)(Kt + (row + 32) * 136 + cc) = R.k2; *(u32x4*)(Kt + (row + 48) * 136 + cc) = R.k3;
  *(u32x4*)(Kt + (row + 64) * 136 + cc) = R.k4; *(u32x4*)(Kt + (row + 80) * 136 + cc) = R.k5;
  *(u32x4*)(Kt + (row + 96) * 136 + cc) = R.k6; *(u32x4*)(Kt + (row + 112) * 136 + cc) = R.k7;
  *(u32x4*)(Vs + row * 136 + cc) = R.v0; *(u32x4*)(Vs + (row + 16) * 136 + cc) = R.v1;
  *(u32x4*)(Vs + (row + 32) * 136 + cc) = R.v2; *(u32x4*)(Vs + (row + 48) * 136 + cc) = R.v3;
  if (step + 2 < 34) scan_issue(p, b, h, dir, s, step + 2, tid, R);
  __syncthreads();
#pragma unroll
  for (int i = 0; i < 8; ++i) S[i] *= gL;
#pragma unroll
  for (int ks = 0; ks < 4; ++ks) {
    bf16x8 bfr = *(const bf16x8*)(Vs + (w * 16 + l15) * 136 + ks * 32 + g * 8);
#pragma unroll
    for (int i = 0; i < 8; ++i) {
      bf16x8 a = *(const bf16x8*)(Kt + (i * 16 + l15) * 136 + ks * 32 + g * 8);
      S[i] = MFMA(a, bfr, S[i]);
    }
  }
}

__device__ __forceinline__ void scan_unit(const Params& p, int u, char* smem, int tid) {
  const int s = u & 3, dir = (u >> 2) & 1, h = (u >> 3) & 3, b = u >> 5;
  u16* Kt = (u16*)smem;
  u16* Vs = Kt + 128 * 136;
  const float lg = dir ? p.ldb[h] : p.ldf[h];
  const float gL = expf(lg * 128.f);
  f32x4 S[8];
#pragma unroll
  for (int i = 0; i < 8; ++i) S[i] = f32x4{0.f, 0.f, 0.f, 0.f};
  ScanRegs RA, RB;
  scan_issue(p, b, h, dir, s, 0, tid, RA);
  scan_issue(p, b, h, dir, s, 1, tid, RB);
#pragma unroll 1
  for (int sp = 0; sp < 17; ++sp) {
    const int step = 2 * sp;
    __syncthreads();
    scan_step(p, RA, S, b, h, dir, s, step, gL, Kt, Vs, tid);
    __syncthreads();
    scan_step(p, RB, S, b, h, dir, s, step + 1, gL, Kt, Vs, tid);
  }
}

__device__ __forceinline__ void stage_q_scaled(u16* Qs, const u16* rq, long t0, int h, const float* tab, int mode, int tid) {
#pragma unroll
  for (int i = 0; i < 8; ++i) {
    int idx = tid + i * 256;
    int row = idx >> 4, cc = (idx & 15) * 8;
    u32x4 v = *(const u32x4*)(rq + (t0 + row) * 512 + h * 128 + cc);
    if (mode != 0) {
      float sc = (mode == 1) ? tab[row + 1] : tab[128 - row];
#pragma unroll
      for (int q = 0; q < 4; ++q) {
        float a = bf2f((u16)(v[q] & 0xffffu)) * sc;
        float bq = bf2f((u16)(v[q] >> 16)) * sc;
        v[q] = pack2(a, bq);
      }
    }
    *(u32x4*)(Qs + row * 136 + cc) = v;
  }
}

__device__ __forceinline__ void rescale_q_inplace(u16* Qs, const float* tF, const float* tFi, const float* tB, int mode, int tid) {
#pragma unroll
  for (int i = 0; i < 8; ++i) {
    int idx = tid + i * 256;
    int row = idx >> 4, cc = (idx & 15) * 8;
    u32x4 v = *(const u32x4*)(Qs + row * 136 + cc);
    const float sc = (mode == 1) ? tF[row + 1] : tB[128 - row] * tFi[row + 1];
#pragma unroll
    for (int q = 0; q < 4; ++q) {
      float a = bf2f((u16)(v[q] & 0xffffu)) * sc;
      float bq = bf2f((u16)(v[q] >> 16)) * sc;
      v[q] = pack2(a, bq);
    }
    *(u32x4*)(Qs + row * 136 + cc) = v;
  }
}

__device__ __forceinline__ void intra_unit(const Params& p, int u, char* smem, int tid) {
  const int c = u & 31, h = (u >> 5) & 3, b = u >> 7;
  u16* Qs = (u16*)smem;
  u16* Ks = Qs + 128 * 136;
  const int lane = tid & 63, w = tid >> 6, l15 = lane & 15, g = lane >> 4;
  const long t0 = (long)b * 4096 + c * 128;
  const u16* rq = (const u16*)(p.ws + OFF_RQ);
  const u16* rk = (const u16*)(p.ws + OFF_RK);
  const u16* rvT = (const u16*)(p.ws + OFF_RVT);
  const u16* sbuf = (const u16*)p.out;
  u16* oraw = (u16*)(p.ws + OFF_ORAW);
  const float lgf = p.ldf[h], lgb = p.ldb[h];
  float* tF = (float*)(smem + 69632);
  float* tFi = tF + 132;
  float* tB = tFi + 132;
  float* tBi = tB + 132;
  __syncthreads();
  if (tid < 129) {
    tF[tid] = expf(lgf * (float)tid);
    tFi[tid] = expf(-lgf * (float)tid);
    tB[tid] = expf(lgb * (float)tid);
    tBi[tid] = expf(-lgb * (float)tid);
  }
  stage_q_scaled(Qs, rq, t0, h, nullptr, 0, tid);
#pragma unroll
  for (int i = 0; i < 8; ++i) {
    int idx = tid + i * 256;
    int row = idx >> 4, cc = (idx & 15) * 8;
    *(u32x4*)(Ks + row * 136 + cc) = *(const u32x4*)(rk + (t0 + row) * 512 + h * 128 + cc);
  }
  __syncthreads();
  {
    f32x4 P[2][8];
#pragma unroll
    for (int i = 0; i < 2; ++i)
#pragma unroll
      for (int j = 0; j < 8; ++j) P[i][j] = f32x4{0.f, 0.f, 0.f, 0.f};
#pragma unroll 1
    for (int ks = 0; ks < 4; ++ks) {
      bf16x8 a0 = *(const bf16x8*)(Qs + (32 * w + l15) * 136 + ks * 32 + g * 8);
      bf16x8 a1 = *(const bf16x8*)(Qs + (32 * w + 16 + l15) * 136 + ks * 32 + g * 8);
#pragma unroll
      for (int nt = 0; nt < 8; ++nt) {
        bf16x8 bb = *(const bf16x8*)(Ks + (nt * 16 + l15) * 136 + ks * 32 + g * 8);
        P[0][nt] = MFMA(a0, bb, P[0][nt]);
        P[1][nt] = MFMA(a1, bb, P[1][nt]);
      }
    }
    __syncthreads();
#pragma unroll
    for (int mt = 0; mt < 2; ++mt)
#pragma unroll
      for (int nt = 0; nt < 8; ++nt)
#pragma unroll
        for (int j = 0; j < 4; ++j) {
          int l = 32 * w + mt * 16 + g * 4 + j;
          int m = nt * 16 + l15;
          float d = (m <= l) ? tF[l] * tFi[m] : tB[m] * tBi[l];
          Ks[l * 136 + m] = f2bf(P[mt][nt][j] * d);
        }
  }
#pragma unroll 1
  for (int hf = 0; hf < 2; ++hf) {
    const int dvb = hf * 128 + w * 32;
    if (hf == 0) rescale_q_inplace(Qs, tF, tFi, tB, 1, tid);
    else stage_q_scaled(Qs, rq, t0, h, tF, 1, tid);
    __syncthreads();
    f32x4 O[8][2];
#pragma unroll
    for (int i = 0; i < 8; ++i) { O[i][0] = f32x4{0.f, 0.f, 0.f, 0.f}; O[i][1] = f32x4{0.f, 0.f, 0.f, 0.f}; }
    {
      const u16* vb = rvT + ((long)((b * 4 + h) * 256 + dvb + l15)) * 4096 + c * 128 + g * 8;
#pragma unroll
      for (int ks = 0; ks < 4; ++ks) {
        bf16x8 bf0 = *(const bf16x8*)(vb + ks * 32);
        bf16x8 bf1 = *(const bf16x8*)(vb + 16L * 4096 + ks * 32);
#pragma unroll
        for (int mt = 0; mt < 8; ++mt) {
          bf16x8 a = *(const bf16x8*)(Ks + (mt * 16 + l15) * 136 + ks * 32 + g * 8);
          O[mt][0] = MFMA(a, bf0, O[mt][0]);
          O[mt][1] = MFMA(a, bf1, O[mt][1]);
        }
      }
    }
    {
      const u16* sb = sbuf + ((((long)(b * 4 + h) * 32 + c) * 2 + 0) * 32768L) + (long)(dvb + l15) * 128 + g * 8;
#pragma unroll
      for (int ks = 0; ks < 4; ++ks) {
        bf16x8 bf0 = *(const bf16x8*)(sb + ks * 32);
        bf16x8 bf1 = *(const bf16x8*)(sb + 16 * 128 + ks * 32);
#pragma unroll
        for (int mt = 0; mt < 8; ++mt) {
          bf16x8 a = *(const bf16x8*)(Qs + (mt * 16 + l15) * 136 + ks * 32 + g * 8);
          O[mt][0] = MFMA(a, bf0, O[mt][0]);
          O[mt][1] = MFMA(a, bf1, O[mt][1]);
        }
      }
    }
    __syncthreads();
    rescale_q_inplace(Qs, tF, tFi, tB, 2, tid);
    __syncthreads();
    {
      const u16* sb = sbuf + ((((long)(b * 4 + h) * 32 + c) * 2 + 1) * 32768L) + (long)(dvb + l15) * 128 + g * 8;
#pragma unroll
      for (int ks = 0; ks < 4; ++ks) {
        bf16x8 bf0 = *(const bf16x8*)(sb + ks * 32);
        bf16x8 bf1 = *(const bf16x8*)(sb + 16 * 128 + ks * 32);
#pragma unroll
        for (int mt = 0; mt < 8; ++mt) {
          bf16x8 a = *(const bf16x8*)(Qs + (mt * 16 + l15) * 136 + ks * 32 + g * 8);
          O[mt][0] = MFMA(a, bf0, O[mt][0]);
          O[mt][1] = MFMA(a, bf1, O[mt][1]);
        }
      }
    }
    __syncthreads();
#pragma unroll
    for (int mt = 0; mt < 8; ++mt)
#pragma unroll
      for (int nt = 0; nt < 2; ++nt)
#pragma unroll
        for (int j = 0; j < 4; ++j) Qs[(mt * 16 + g * 4 + j) * 136 + w * 32 + nt * 16 + l15] = f2bf(O[mt][nt][j]);
    __syncthreads();
#pragma unroll
    for (int i = 0; i < 8; ++i) {
      int idx = tid + i * 256;
      int row = idx >> 4, cc = (idx & 15) * 8;
      *(u32x4*)(oraw + (t0 + row) * 1024 + h * 256 + hf * 128 + cc) = *(const u32x4*)(Qs + row * 136 + cc);
    }
    __syncthreads();
  }
  u16* rg = (u16*)(p.ws + OFF_RG);
#pragma unroll 1
  for (int rb = 0; rb < 4; ++rb) {
    u32x2 ovv[8], gvv[8];
#pragma unroll
    for (int r = 0; r < 8; ++r) {
      const long l = t0 + 32 * w + rb * 8 + r;
      ovv[r] = *(const u32x2*)(oraw + l * 1024 + h * 256 + lane * 4);
      gvv[r] = *(const u32x2*)(rg + l * 1024 + h * 256 + lane * 4);
    }
#pragma unroll
    for (int r = 0; r < 8; ++r) {
      const long l = t0 + 32 * w + rb * 8 + r;
      const u32x2 ov = ovv[r], gv = gvv[r];
      float x0 = bf2f((u16)(ov.x & 0xffffu)), x1 = bf2f((u16)(ov.x >> 16)), x2 = bf2f((u16)(ov.y & 0xffffu)), x3 = bf2f((u16)(ov.y >> 16));
      float mu = wave_sum(x0 + x1 + x2 + x3) * (1.f / 256.f);
      float d0 = x0 - mu, d1 = x1 - mu, d2 = x2 - mu, d3 = x3 - mu;
      float var = wave_sum(d0 * d0 + d1 * d1 + d2 * d2 + d3 * d3) * (1.f / 256.f);
      float rstd = rsqrtf(var + 1e-6f);
      float g0 = bf2f((u16)(gv.x & 0xffffu)), g1 = bf2f((u16)(gv.x >> 16)), g2 = bf2f((u16)(gv.y & 0xffffu)), g3 = bf2f((u16)(gv.y >> 16));
      *(u32x2*)(rg + l * 1024 + h * 256 + lane * 4) = pack4(d0 * rstd * siluf_(g0), d1 * rstd * siluf_(g1), d2 * rstd * siluf_(g2), d3 * rstd * siluf_(g3));
    }
  }
}

__device__ __forceinline__ GA merge_ga(const Params& p, int step, int m0, int n0) {
  GA g;
  if (step == 0)      { g.A = (const u16*)(p.ws + OFF_HX) + (long)m0 * 1024;  g.B = (const u16*)(p.ws + OFF_WIN) + (long)(4608 + n0) * 1024; g.lda = 1024; g.ldb = 1024; }
  else if (step == 1) { g.A = (const u16*)(p.ws + OFF_NAQ) + (long)m0 * 512;  g.B = (const u16*)(p.ws + OFF_WPNA) + (long)n0 * 512;          g.lda = 512;  g.ldb = 512; }
  else if (step == 2) { g.A = (const u16*)(p.ws + OFF_HX) + (long)m0 * 1024;  g.B = (const u16*)(p.ws + OFF_WIN) + (long)(5632 + n0) * 1024; g.lda = 1024; g.ldb = 1024; }
  else                { g.A = (const u16*)(p.ws + OFF_RG) + (long)m0 * 1024;  g.B = (const u16*)(p.ws + OFF_WPRET) + (long)n0 * 1024;        g.lda = 1024; g.ldb = 1024; }
  return g;
}
#define F32_EPILOGUE(BODY)                                                              \
  {                                                                                     \
    float* st_ = (float*)(smem + WST_OFF + wid * WST_BYTES);                            \
    _Pragma("unroll") for (int ps_ = 0; ps_ < 4; ++ps_) {                               \
      _Pragma("unroll") for (int m2_ = 0; m2_ < 2; ++m2_)                               \
        _Pragma("unroll") for (int n_ = 0; n_ < 4; ++n_)                                \
          *(f32x4*)(st_ + (m2_ * 16 + fr) * 68 + n_ * 16 + fq * 4) = acc[ps_ * 2 + m2_][n_]; \
      _Pragma("unroll") for (int i_ = 0; i_ < 8; ++i_) {                                \
        const int id_ = lane + i_ * 64;                                                 \
        const int rl_ = id_ >> 4, c4_ = (id_ & 15) * 4;                                 \
        const int rt = wr * 128 + ps_ * 32 + rl_, ct = wc * 64 + c4_;                   \
        const f32x4 a4 = *(const f32x4*)(st_ + rl_ * 68 + c4_);                         \
        BODY                                                                            \
      }                                                                                 \
    }                                                                                   \
  }

template <int STEP>
__device__ __forceinline__ void merge_step(const Params& p, int m0, int n0, char* smem, bool pre, GA nx) {
  EPI_IDS;
  u16* park1 = (u16*)p.out;
  u16* park2 = (u16*)(p.ws + OFF_PARK2);
  u16* merged = (u16*)(p.ws + OFF_MERGED);
  f32x4 acc[8][4];
  zero_acc(acc);
  {
    GA g = merge_ga(p, STEP, m0, n0);
    gemm256<true>(acc, g.A, g.lda, g.B, g.ldb, (STEP == 1) ? 512 : 1024, smem, pre, nx);
  }
  if (STEP == 0 || STEP == 2) {
    u16* dst = (STEP == 0) ? park1 : park2;
    F32_EPILOGUE({
      *(u32x2*)(dst + (long)(m0 + rt) * 1024 + n0 + ct) = pack4(sigmoidf_(a4[0]), sigmoidf_(a4[1]), sigmoidf_(a4[2]), sigmoidf_(a4[3]));
    })
  } else if (STEP == 1) {
    F32_EPILOGUE({
      u16* d = park1 + (long)(m0 + rt) * 1024 + n0 + ct;
      u32x2 g2 = *(const u32x2*)d;
      *(u32x2*)d = pack4(bf2f((u16)(g2.x & 0xffffu)) * a4[0], bf2f((u16)(g2.x >> 16)) * a4[1],
                         bf2f((u16)(g2.y & 0xffffu)) * a4[2], bf2f((u16)(g2.y >> 16)) * a4[3]);
    })
  } else {
    F32_EPILOGUE({
      const long off = (long)(m0 + rt) * 1024 + n0 + ct;
      u32x2 a = *(const u32x2*)(park1 + off);
      u32x2 gb = *(const u32x2*)(park2 + off);
      *(u32x2*)(merged + off) = pack4(bf2f((u16)(a.x & 0xffffu)) + bf2f((u16)(gb.x & 0xffffu)) * a4[0],
                                      bf2f((u16)(a.x >> 16)) + bf2f((u16)(gb.x >> 16)) * a4[1],
                                      bf2f((u16)(a.y & 0xffffu)) + bf2f((u16)(gb.y & 0xffffu)) * a4[2],
                                      bf2f((u16)(a.y >> 16)) + bf2f((u16)(gb.y >> 16)) * a4[3]);
    })
  }
  asm volatile("" ::: "memory");
}

__device__ __forceinline__ GA outproj_ga(const Params& p, int id) {
  GA g; g.A = nullptr; g.B = nullptr; g.lda = 1024; g.ldb = 1024;
  if (id < 512) {
    int mt_, nt_;
    tile_mn(id, 4, mt_, nt_);
    g.A = (const u16*)(p.ws + OFF_MERGED) + (long)mt_ * 256 * 1024;
    g.B = (const u16*)(p.ws + OFF_WOUT) + (long)nt_ * 256 * 1024;
  }
  return g;
}
__device__ __forceinline__ void outproj_tile(const Params& p, int id, char* smem, bool pre, GA nx) {
  int mt_, nt_;
  tile_mn(id, 4, mt_, nt_);
  const int m0 = mt_ * 256, n0 = nt_ * 256;
  EPI_IDS;
  f32x4 acc[8][4];
  zero_acc(acc);
  gemm256<true>(acc, (const u16*)(p.ws + OFF_MERGED) + (long)m0 * 1024, 1024, (const u16*)(p.ws + OFF_WOUT) + (long)n0 * 1024, 1024, 1024, smem, pre, nx);
  const float* mod = (const float*)(p.ws + OFF_MOD);
  const int bb = m0 >> 12;
  F32_EPILOGUE({
    const long off = (long)(m0 + rt) * 1024 + n0 + ct;
    const f32x4 xv = __builtin_nontemporal_load((const f32x4*)(p.x + off));
    float4 gv = *(const float4*)(mod + bb * 6144 + 2048 + n0 + ct);
    f32x4 o;
    o[0] = xv[0] + gv.x * a4[0];
    o[1] = xv[1] + gv.y * a4[1];
    o[2] = xv[2] + gv.z * a4[2];
    o[3] = xv[3] + gv.w * a4[3];
    __builtin_nontemporal_store(o, (f32x4*)(p.out + off));
  })
}

__device__ __forceinline__ int ffn_h(int half) { return half ? 1280 : 1536; }
__device__ __forceinline__ int ffn_a0(int half) { return half ? 1536 : 0; }

__device__ __forceinline__ GA up_ga(const Params& p, int half, int id) {
  const int H = ffn_h(half), a0 = ffn_a0(half), NT = 2 * H / 256, NA_ = H / 256;
  GA g; g.A = nullptr; g.B = nullptr; g.lda = 1024; g.ldb = 1024;
  if (id < 128 * NT) {
    int mt_, j;
    tile_mn(id, NT, mt_, j);
    const int wrow = (j < NA_) ? (a0 + j * 256) : (2816 + a0 + (j - NA_) * 256);
    g.A = (const u16*)(p.ws + OFF_HX) + (long)mt_ * 256 * 1024;
    g.B = (const u16*)(p.ws + OFF_WUP) + (long)wrow * 1024;
  }
  return g;
}
__device__ __forceinline__ void up_tile(const Params& p, int half, int id, char* smem, bool pre, GA nx) {
  const int H = ffn_h(half), a0 = ffn_a0(half), NT = 2 * H / 256, NA_ = H / 256;
  int mt_, j;
  tile_mn(id, NT, mt_, j);
  const int m0 = mt_ * 256;
  const int wrow = (j < NA_) ? (a0 + j * 256) : (2816 + a0 + (j - NA_) * 256);
  EPI_IDS;
  f32x4 acc[8][4];
  zero_acc(acc);
  gemm256<true>(acc, (const u16*)(p.ws + OFF_HX) + (long)m0 * 1024, 1024, (const u16*)(p.ws + OFF_WUP) + (long)wrow * 1024, 1024, 1024, smem, pre, nx);
  u16* uh = (u16*)(p.ws + OFF_UH);
  const long us = 2 * H;
  wave_store_nat_bf16(acc, smem, uh + (long)(m0 + wr * 128) * us + j * 256 + wc * 64, us, 1.f, wid, lane, fr, fq);
}

__device__ __forceinline__ void act_unit(const Params& p, int half, int u, int tid) {
  const int H = ffn_h(half), a0 = ffn_a0(half), CH = H / 8;
  const int item = u * 256 + tid;
  if (item >= 4096 * CH) return;
  const int seg = item / CH, ch = item % CH;
  const int t0 = seg * 8;
  const int f = ch * 8;
  const int ca = a0 + f, cv = 2816 + a0 + f;
  const long us = 2 * H;
  const u16* uh = (const u16*)(p.ws + OFF_UH);
  u16* hact = (u16*)(p.ws + OFF_HACT);
  const bool has_prev = (t0 & 4095) != 0, has_next = ((t0 + 8) & 4095) != 0;
  const u32x4 z = {0u, 0u, 0u, 0u};
  u32x4 ra[10], rv[10];
#pragma unroll
  for (int i = 0; i < 10; ++i) {
    const bool ok = (i == 0) ? has_prev : ((i == 9) ? has_next : true);
    const long tr = ok ? (long)(t0 - 1 + i) : (long)t0;
    ra[i] = __builtin_nontemporal_load((const u32x4*)(uh + tr * us + f));
    rv[i] = __builtin_nontemporal_load((const u32x4*)(uh + tr * us + H + f));
    if (!ok) { ra[i] = z; rv[i] = z; }
  }
  float wa[3][8], wv[3][8], ba[8], bv[8];
#pragma unroll
  for (int i = 0; i < 3; ++i)
#pragma unroll
    for (int q = 0; q < 8; ++q) {
      wa[i][q] = p.conv_w[i * 5632 + ca + q];
      wv[i][q] = p.conv_w[i * 5632 + cv + q];
    }
#pragma unroll
  for (int q = 0; q < 8; ++q) { ba[q] = p.conv_b[ca + q]; bv[q] = p.conv_b[cv + q]; }
#pragma unroll
  for (int i = 0; i < 8; ++i) {
    unsigned o[4];
#pragma unroll
    for (int q = 0; q < 4; ++q) {
      float a_lo = bf2f((u16)(ra[i][q] & 0xffffu)) * wa[0][2 * q] + bf2f((u16)(ra[i + 1][q] & 0xffffu)) * wa[1][2 * q] + bf2f((u16)(ra[i + 2][q] & 0xffffu)) * wa[2][2 * q] + ba[2 * q];
      float a_hi = bf2f((u16)(ra[i][q] >> 16)) * wa[0][2 * q + 1] + bf2f((u16)(ra[i + 1][q] >> 16)) * wa[1][2 * q + 1] + bf2f((u16)(ra[i + 2][q] >> 16)) * wa[2][2 * q + 1] + ba[2 * q + 1];
      float v_lo = bf2f((u16)(rv[i][q] & 0xffffu)) * wv[0][2 * q] + bf2f((u16)(rv[i + 1][q] & 0xffffu)) * wv[1][2 * q] + bf2f((u16)(rv[i + 2][q] & 0xffffu)) * wv[2][2 * q] + bv[2 * q];
      float v_hi = bf2f((u16)(rv[i][q] >> 16)) * wv[0][2 * q + 1] + bf2f((u16)(rv[i + 1][q] >> 16)) * wv[1][2 * q + 1] + bf2f((u16)(rv[i + 2][q] >> 16)) * wv[2][2 * q + 1] + bv[2 * q + 1];
      o[q] = pack2(siluf_(a_lo) * v_lo, siluf_(a_hi) * v_hi);
    }
    *(u32x4*)(hact + (long)(t0 + i) * 2816 + a0 + f) = u32x4{o[0], o[1], o[2], o[3]};
  }
}
__device__ __forceinline__ int act_units(int half) { return 4096 * (ffn_h(half) / 8) / 256; }

__device__ __forceinline__ GA down_ga(const Params& p, int half, int id) {
  const int H = 2816, a0 = 0; (void)half;
  GA g; g.A = nullptr; g.B = nullptr; g.lda = H; g.ldb = 2816;
  if (id < 512) {
    int mt_, nt_;
    tile_mn(id, 4, mt_, nt_);
    g.A = (const u16*)(p.ws + OFF_HACT) + (long)mt_ * 256 * H;
    g.B = (const u16*)(p.ws + OFF_WDOWN) + (long)nt_ * 256 * 2816 + a0;
  }
  return g;
}
__device__ __forceinline__ void down_tile(const Params& p, int half, int id, char* smem, bool pre, GA nx) {
  const int H = 2816, a0 = 0; (void)half;
  int mt_, nt_;
  tile_mn(id, 4, mt_, nt_);
  const int m0 = mt_ * 256, n0 = nt_ * 256;
  EPI_IDS;
  f32x4 acc[8][4];
  zero_acc(acc);
  gemm256<true>(acc, (const u16*)(p.ws + OFF_HACT) + (long)m0 * H, H, (const u16*)(p.ws + OFF_WDOWN) + (long)n0 * 2816 + a0, 2816, H, smem, pre, nx);
  const float* mod = (const float*)(p.ws + OFF_MOD);
  const int bb = m0 >> 12;
  F32_EPILOGUE({
    const long off = (long)(m0 + rt) * 1024 + n0 + ct;
    f32x4 xv = __builtin_nontemporal_load((const f32x4*)(p.out + off));
    float4 gv = *(const float4*)(mod + bb * 6144 + 5120 + n0 + ct);
    xv[0] += gv.x * a4[0];
    xv[1] += gv.y * a4[1];
    xv[2] += gv.z * a4[2];
    xv[3] += gv.w * a4[3];
    __builtin_nontemporal_store(xv, (f32x4*)(p.out + off));
  })
}

#define XB_TMO      128
#define XB_XCNT(j)  (256  + 64 * (j))
#define XB_XSUB(j)  (1280 + 64 * (j))
#define XB_XGEN(j)  (2304 + 64 * (j))
#define XB_TOP      3328
#define XB_TOPGEN   3392
#define XCD_BAR_WORDS 3456
#define XB_SPIN_CAP (1u << 18)
#define LAS __attribute__((address_space(3)))

__device__ __forceinline__ unsigned xb_ld(unsigned* p)              { return __hip_atomic_load(p, __ATOMIC_RELAXED, __HIP_MEMORY_SCOPE_AGENT); }
__device__ __forceinline__ unsigned xb_add(unsigned* p, unsigned v) { return __hip_atomic_fetch_add(p, v, __ATOMIC_RELAXED, __HIP_MEMORY_SCOPE_AGENT); }
__device__ __forceinline__ unsigned xb_xcc_id() { return (unsigned)__builtin_amdgcn_s_getreg((3 << 11) | 20) & 0xFu; }
#define XB_SPIN(cond, bar) do { unsigned _sp = 0; while (cond) { __builtin_amdgcn_s_sleep(1); \
    if ((++_sp & 255u) == 0u) { if (xb_ld(&(bar)[XB_TMO])) break; if (_sp > XB_SPIN_CAP) { atomicAdd(&(bar)[XB_TMO], 1u); break; } } } } while (0)

struct XcdBarrier {
    unsigned* bar; unsigned x;
    volatile LAS unsigned* st;
};

__device__ __forceinline__ XcdBarrier xcd_barrier_post(unsigned* bar, volatile LAS unsigned* st) {
    XcdBarrier b; b.bar = bar; b.x = xb_xcc_id(); b.st = st;
    if (threadIdx.x == 0) (void)xb_add(&bar[XB_XCNT(b.x)], 1u);
    return b;
}
__device__ __forceinline__ void xcd_barrier_complete(unsigned* bar, unsigned x, unsigned& nloc, unsigned& nx) {
    const unsigned G = gridDim.x * gridDim.y * gridDim.z;
    unsigned sum, cnt, mine, sp = 0u;
    for (;;) {
        sum = 0u; cnt = 0u; mine = 0u;
#pragma unroll
        for (unsigned j = 0; j < 16; ++j) { const unsigned c = xb_ld(&bar[XB_XCNT(j)]); sum += c; cnt += (c > 0u) ? 1u : 0u; mine = (j == x) ? c : mine; }
        if (sum == G) break;
        __builtin_amdgcn_s_sleep(1);
        if ((++sp & 255u) == 0u) { if (xb_ld(&bar[XB_TMO])) break; if (sp > XB_SPIN_CAP) { atomicAdd(&bar[XB_TMO], 1u); break; } }
    }
    nloc = mine > 0u ? mine : 1u; nx = cnt > 0u ? cnt : 1u;
}

__device__ __forceinline__ void xcd_barrier(const XcdBarrier& b) {
    asm volatile("s_waitcnt vmcnt(0)" ::: "memory");
    __syncthreads();
    if (threadIdx.x == 0) {
        unsigned* bar = b.bar;
        __builtin_amdgcn_s_waitcnt(0);
        unsigned nloc = b.st[0], nx = b.st[1];
        if (nloc == 0u) { xcd_barrier_complete(bar, b.x, nloc, nx); b.st[0] = nloc; b.st[1] = nx; }
        const unsigned old = xb_add(&bar[XB_XSUB(b.x)], 1u);
        const unsigned gen = old / nloc;
        if (old + 1u == (gen + 1u) * nloc) {
            __builtin_amdgcn_fence(__ATOMIC_RELEASE, "agent");
            asm volatile("s_waitcnt vmcnt(0)" ::: "memory");
            const unsigned og = xb_add(&bar[XB_TOP], 1u);
            const unsigned tg = og / nx;
            if (og + 1u == (tg + 1u) * nx) xb_add(&bar[XB_TOPGEN], 1u);
            else XB_SPIN(xb_ld(&bar[XB_TOPGEN]) == tg, bar);
            __builtin_amdgcn_fence(__ATOMIC_ACQUIRE, "agent");
            xb_add(&bar[XB_XGEN(b.x)], 1u);
            asm volatile("s_waitcnt vmcnt(0)" ::: "memory");
        } else {
            XB_SPIN(xb_ld(&bar[XB_XGEN(b.x)]) == gen, bar);
            __builtin_amdgcn_fence(__ATOMIC_ACQUIRE, "agent");
            asm volatile("s_waitcnt vmcnt(0)" ::: "memory");
        }
    }
    __syncthreads();
}


__global__ void __launch_bounds__(512, 2) mega(Params pk) {
  extern __shared__ __attribute__((aligned(1024))) char smem[];
  Params& p_sh = *(Params*)(smem + PARAM_OFF);
  if (threadIdx.x == 0) {
    p_sh.x = pk.x; p_sh.c = pk.c; p_sh.ctx = pk.ctx; p_sh.c_ctx = pk.c_ctx; p_sh.w_ada = pk.w_ada; p_sh.b_ada = pk.b_ada;
    p_sh.norm1_g = pk.norm1_g; p_sh.w_in = pk.w_in; p_sh.na_rpb = pk.na_rpb; p_sh.ldf = pk.ldf; p_sh.ldb = pk.ldb;
    p_sh.w_pna = pk.w_pna; p_sh.w_pret = pk.w_pret; p_sh.w_out = pk.w_out; p_sh.norm2_g = pk.norm2_g; p_sh.w_up = pk.w_up;
    p_sh.conv_w = pk.conv_w; p_sh.conv_b = pk.conv_b; p_sh.w_down = pk.w_down; p_sh.final_g = pk.final_g;
    p_sh.out = pk.out; p_sh.ws = pk.ws;
  }
  volatile LAS unsigned* xb_st = (volatile LAS unsigned*)(smem + PARAM_OFF + 192);
  if (threadIdx.x == 0) { xb_st[0] = 0u; xb_st[1] = 0u; }
  unsigned* xb_bar = (unsigned*)(pk.ws + WS_END);
  if (blockIdx.x == 0) for (int i = threadIdx.x; i < XCD_BAR_WORDS; i += 512) xb_bar[i] = 0u;
  __syncthreads();
  const Params& p = p_sh;
  cg::grid_group grid = cg::this_grid();
  const int nb = gridDim.x, bid = blockIdx.x;
#define VB_IDS                                                                        \
  int tid_ = threadIdx.x; asm volatile("" : "+v"(tid_));                              \
  const int hb = tid_ >> 8, vtid = tid_ & 255, vb = bid * 2 + hb, nvb = nb * 2, w8 = tid_ >> 6; \
  char* hsm = smem + hb * HALF_LDS;                                                   \
  const float* mod = (const float*)(p.ws + OFF_MOD);                                  \
  (void)vtid; (void)vb; (void)nvb; (void)w8; (void)hsm; (void)mod
#define GSYNC()                                                                       \
  do {                                                                                \
    XcdBarrier b_;                                                                    \
    b_.bar = (unsigned*)(p.ws + WS_END);                                              \
    b_.st = (volatile LAS unsigned*)(smem + PARAM_OFF + 192);                         \
    b_.x = b_.st[2];                                                                  \
    xcd_barrier(b_);                                                                  \
  } while (0)

  { VB_IDS; for (int u = vb; u < P0_UNITS; u += nvb) p0_unit(p, u, hsm, vtid); }
  grid.sync();
  {
    const XcdBarrier xb0 = xcd_barrier_post((unsigned*)(p.ws + WS_END), (volatile LAS unsigned*)(smem + PARAM_OFF + 192));
    if (threadIdx.x == 0) ((volatile LAS unsigned*)(smem + PARAM_OFF + 192))[2] = xb0.x;
    __syncthreads();
  }
  for (int u = bid; u < (T + TC) / 16; u += nb) {
    VB_IDS;
    int row = u * 16 + w8 * 2;
    if (row < T) {
      int b = row >> 12;
      rownorm2_bf16(p.x + (long)row * 1024, p.norm1_g, mod + b * 6144, mod + b * 6144 + 1024, (u16*)(p.ws + OFF_HX) + (long)row * 1024);
    } else {
      rownorm2_bf16(p.ctx + (long)(row - T) * 1024, p.norm1_g, mod + 8 * 6144, mod + 8 * 6144 + 1024, (u16*)(p.ws + OFF_HX) + (long)row * 1024);
    }
  }
  GSYNC();
  {
    bool pre = false;
    for (int u = bid; u < 2304 + 80; u += nb) { GA nx = inproj_ga(p, 1 << 30); inproj_tile(p, u, smem, pre, nx); pre = false; }
  }
  GSYNC();
  {
    VB_IDS;
    if (nb == 256) {
      if (bid < 128) {
        scan_unit(p, vb, hsm, vtid);
        na_run(p, 2816 + bid * 10 + hb, 2, 5, hsm, vtid);
      } else {
        na_run(p, (bid - 128) * 22 + hb, 2, 11, hsm, vtid);
      }
    } else {
      for (int u = vb; u < 256; u += nvb) scan_unit(p, u, hsm, vtid);
      int cnt = (4096 - vb + nvb - 1) / nvb;
      na_run(p, vb, nvb, cnt, hsm, vtid);
    }
  }
  GSYNC();
  { VB_IDS; for (int u = vb; u < 1024; u += nvb) intra_unit(p, u, hsm, vtid); }
  GSYNC();
  {
    bool pre = false;
    for (int u = bid; u < 512; u += nb) {
      int mt_, nt_;
      tile_mn(u, 4, mt_, nt_);
      const int m0 = mt_ * 256, n0 = nt_ * 256;
      GA nx; nx.A = nullptr; nx.B = nullptr; nx.lda = 1024; nx.ldb = 1024;
      merge_step<0>(p, m0, n0, smem, false, nx);
      merge_step<1>(p, m0, n0, smem, false, nx);
      merge_step<2>(p, m0, n0, smem, false, nx);
      merge_step<3>(p, m0, n0, smem, false, nx);
      (void)pre;
    }
  }
  GSYNC();
  {
    bool pre = false;
    for (int u = bid; u < 512; u += nb) { GA nx = outproj_ga(p, 1 << 30); outproj_tile(p, u, smem, pre, nx); pre = false; }
  }
  GSYNC();
  for (int u = bid; u < T / 16; u += nb) {
    VB_IDS;
    int row = u * 16 + w8 * 2;
    int b = row >> 12;
    rownorm2_bf16(p.out + (long)row * 1024, p.norm2_g, mod + b * 6144 + 3072, mod + b * 6144 + 4096, (u16*)(p.ws + OFF_HX) + (long)row * 1024);
  }
  GSYNC();
  {
    bool pre = false;
    for (int u = bid; u < 128 * 12; u += nb) { GA nx = up_ga(p, 0, 1 << 30); up_tile(p, 0, u, smem, pre, nx); pre = false; }
  }
  GSYNC();
  { VB_IDS; for (int u = vb; u < act_units(0); u += nvb) act_unit(p, 0, u, vtid); }
  GSYNC();
  {
    bool pre = false;
    for (int u = bid; u < 128 * 10; u += nb) { GA nx = up_ga(p, 1, 1 << 30); up_tile(p, 1, u, smem, pre, nx); pre = false; }
  }
  GSYNC();
  { VB_IDS; for (int u = vb; u < act_units(1); u += nvb) act_unit(p, 1, u, vtid); }
  GSYNC();
  {
    bool pre = false;
    for (int u = bid; u < 512; u += nb) { GA nx = down_ga(p, 1, 1 << 30); down_tile(p, 1, u, smem, pre, nx); pre = false; }
  }
  GSYNC();
  for (int u = bid; u < T / 16; u += nb) {
    VB_IDS;
    int row = u * 16 + w8 * 2;
    const int lane = tid_ & 63;
    float* src = p.out + (long)row * 1024;
    float4 v[2][4];
#pragma unroll
    for (int r = 0; r < 2; ++r)
#pragma unroll
      for (int i = 0; i < 4; ++i) {
        const f32x4 t4 = __builtin_nontemporal_load((const f32x4*)(src + r * 1024) + lane + i * 64);
        v[r][i].x = t4[0]; v[r][i].y = t4[1]; v[r][i].z = t4[2]; v[r][i].w = t4[3];
      }
    float ss0 = 0.f, ss1 = 0.f;
#pragma unroll
    for (int i = 0; i < 4; ++i) {
      ss0 += v[0][i].x * v[0][i].x + v[0][i].y * v[0][i].y + v[0][i].z * v[0][i].z + v[0][i].w * v[0][i].w;
      ss1 += v[1][i].x * v[1][i].x + v[1][i].y * v[1][i].y + v[1][i].z * v[1][i].z + v[1][i].w * v[1][i].w;
    }
    ss0 = wave_sum(ss0);
    ss1 = wave_sum(ss1);
    const float r0 = rsqrtf(ss0 * (1.f / 1024.f) + 1e-6f), r1 = rsqrtf(ss1 * (1.f / 1024.f) + 1e-6f);
#pragma unroll
    for (int i = 0; i < 4; ++i) {
      float4 gn = ((const float4*)p.final_g)[lane + i * 64];
      float4 o0, o1;
      o0.x = v[0][i].x * r0 * gn.x; o0.y = v[0][i].y * r0 * gn.y; o0.z = v[0][i].z * r0 * gn.z; o0.w = v[0][i].w * r0 * gn.w;
      o1.x = v[1][i].x * r1 * gn.x; o1.y = v[1][i].y * r1 * gn.y; o1.z = v[1][i].z * r1 * gn.z; o1.w = v[1][i].w * r1 * gn.w;
      __builtin_nontemporal_store(f32x4{o0.x, o0.y, o0.z, o0.w}, (f32x4*)src + lane + i * 64);
      __builtin_nontemporal_store(f32x4{o1.x, o1.y, o1.z, o1.w}, (f32x4*)(src + 1024) + lane + i * 64);
    }
  }
}

extern "C" void kernel_launch(void* const* d_in, const int* in_sizes, int n_in, void* d_out, int out_size, void* d_ws,
                              size_t ws_size, hipStream_t stream) {
  static int grid_blocks = 0;
  if (grid_blocks == 0) {
    if (n_in != 20 || ws_size < (size_t)WS_END + 16384 || out_size != T * 1024) {
      fprintf(stderr, "kernel_launch: unexpected sizes n_in=%d ws=%zu out=%d (need ws >= %ld)\n", n_in, ws_size, out_size, (long)WS_END);
      grid_blocks = -1;
      return;
    }
    int dev = 0, cus = 0, per_cu = 0;
    hipGetDevice(&dev);
    hipDeviceGetAttribute(&cus, hipDeviceAttributeMultiprocessorCount, dev);
    hipFuncSetAttribute((const void*)mega, hipFuncAttributeMaxDynamicSharedMemorySize, LDS_BYTES);
    hipOccupancyMaxActiveBlocksPerMultiprocessor(&per_cu, (const void*)mega, 512, LDS_BYTES);
    if (per_cu < 1) per_cu = 1;
    if (per_cu > 1) per_cu = 1;
    grid_blocks = cus * per_cu;
    fprintf(stderr, "kernel_launch: cus=%d per_cu=%d grid=%d\n", cus, per_cu, grid_blocks);
  }
  if (grid_blocks < 0) return;
  Params p{};
  p.x = (const float*)d_in[0]; p.c = (const float*)d_in[1]; p.ctx = (const float*)d_in[2]; p.c_ctx = (const float*)d_in[3];
  p.w_ada = (const float*)d_in[4]; p.b_ada = (const float*)d_in[5]; p.norm1_g = (const float*)d_in[6]; p.w_in = (const float*)d_in[7];
  p.na_rpb = (const float*)d_in[8]; p.ldf = (const float*)d_in[9]; p.ldb = (const float*)d_in[10]; p.w_pna = (const float*)d_in[11];
  p.w_pret = (const float*)d_in[12]; p.w_out = (const float*)d_in[13]; p.norm2_g = (const float*)d_in[14]; p.w_up = (const float*)d_in[15];
  p.conv_w = (const float*)d_in[16]; p.conv_b = (const float*)d_in[17]; p.w_down = (const float*)d_in[18]; p.final_g = (const float*)d_in[19];
  p.out = (float*)d_out;
  p.ws = (char*)d_ws;
  void* args[] = {&p};
  hipError_t e = hipLaunchCooperativeKernel((const void*)mega, dim3(grid_blocks), dim3(512), args, LDS_BYTES, stream);
  if (e != hipSuccess) fprintf(stderr, "cooperative launch failed: %s (grid %d)\n", hipGetErrorString(e), grid_blocks);
}
```

```cpp
#include <hip/hip_runtime.h>
#include <hip/hip_cooperative_groups.h>
#include <cstdio>
namespace cg = cooperative_groups;

typedef unsigned short u16;
typedef __attribute__((ext_vector_type(8))) short bf16x8;
typedef __attribute__((ext_vector_type(4))) short bf16x4;
typedef __attribute__((ext_vector_type(4))) float f32x4;
typedef __attribute__((ext_vector_type(4))) unsigned int u32x4;
typedef __attribute__((ext_vector_type(2))) unsigned int u32x2;

constexpr int T = 32768, TC = 2048;
constexpr long SEG = 33554432L;

constexpr long OFF_WIN = 0;
constexpr long OFF_WPNA = 13631488L;
constexpr long OFF_WPRET = 14680064L;
constexpr long OFF_WOUT = 16777216L;
constexpr long OFF_WUP = 18874368L;
constexpr long OFF_WDOWN = 30408704L;
constexpr long OFF_MOD = 36175872L;
constexpr long OFF_ROPE = 36397056L;
constexpr long OFF_HX = 37748736L;
constexpr long OFF_Y = 109051904L;
constexpr long OFF_NAQ = OFF_Y;
constexpr long OFF_NAK = OFF_Y + SEG;
constexpr long OFF_NAVT = OFF_Y + 2 * SEG;
constexpr long OFF_RQ = OFF_Y + 3 * SEG;
constexpr long OFF_RK = OFF_Y + 4 * SEG;
constexpr long OFF_KTF = OFF_Y + 5 * SEG;
constexpr long OFF_KTB = OFF_Y + 6 * SEG;
constexpr long OFF_RVT = OFF_Y + 7 * SEG;
constexpr long OFF_RG = OFF_Y + 9 * SEG;
constexpr long OFF_CNAK = OFF_Y + 11 * SEG;
constexpr long OFF_CNAVT = OFF_CNAK + 2097152L;
constexpr long OFF_CKTF = OFF_CNAVT + 2097152L;
constexpr long OFF_CKTB = OFF_CKTF + 2097152L;
constexpr long OFF_CRVT = OFF_CKTB + 2097152L;
constexpr long WS_END = OFF_CRVT + 4194304L;
constexpr long OFF_MERGED = OFF_RVT;
constexpr long OFF_ORAW = OFF_KTF;
constexpr long OFF_PARK2 = OFF_RQ;
constexpr long OFF_HACTF = OFF_HX + (long)T * 2048;
constexpr long OFF_UH = OFF_HACTF + (long)T * 2816 * 2;
constexpr long OFF_HACT = OFF_HACTF;
static_assert(OFF_UH + (long)T * 3072 * 2 <= WS_END, "FFN scratch must fit the workspace map");

constexpr int HALF_LDS = 73728;
constexpr int PARAM_OFF = 2 * HALF_LDS;
constexpr int LDS_BYTES = PARAM_OFF + 256;

struct Params {
  const float *x, *c, *ctx, *c_ctx, *w_ada, *b_ada, *norm1_g, *w_in, *na_rpb, *ldf, *ldb, *w_pna, *w_pret, *w_out,
      *norm2_g, *w_up, *conv_w, *conv_b, *w_down, *final_g;
  float* out;
  char* ws;
};

typedef float f32x2_t __attribute__((ext_vector_type(2)));
typedef __bf16 bf16x2_t __attribute__((ext_vector_type(2)));
__device__ __forceinline__ unsigned pack2(float a, float b) {
  f32x2_t v = {a, b};
  bf16x2_t r = __builtin_convertvector(v, bf16x2_t);
  return __builtin_bit_cast(unsigned, r);
}
__device__ __forceinline__ u16 f2bf(float f) { return (u16)(pack2(f, 0.f) & 0xffffu); }
__device__ __forceinline__ float bf2f(u16 h) { return __uint_as_float(((unsigned)h) << 16); }
__device__ __forceinline__ u32x2 pack4(float a, float b, float c, float d) {
  u32x2 r = {pack2(a, b), pack2(c, d)}; return r;
}
__device__ __forceinline__ float sigmoidf_(float x) { return __builtin_amdgcn_rcpf(1.f + __expf(-x)); }
__device__ __forceinline__ float siluf_(float x) { return x * __builtin_amdgcn_rcpf(1.f + __expf(-x)); }

#define MFMA(a, b, c) __builtin_amdgcn_mfma_f32_16x16x32_bf16((a), (b), (c), 0, 0, 0)

__device__ __forceinline__ int lds_byte2(int r, int c) {
  int st = (r >> 4) * 2 + (c >> 5), ob = (r & 15) * 64 + (c & 31) * 2;
  return st * 1024 + (ob ^ (((ob >> 9) & 1) << 5));
}
__device__ __forceinline__ void stage_rc2(int b, int& R, int& C) {
  int st = b >> 10, sb = b & 1023, swz = sb ^ (((sb >> 9) & 1) << 5);
  R = (st >> 1) * 16 + swz / 64;
  C = (st & 1) * 32 + (swz % 64) / 2;
}
struct GA { const u16* A; const u16* B; int lda, ldb; };
template <bool SWAP>
__device__ __forceinline__ void gemm256(f32x4 (&acc)[8][4], const u16* __restrict__ A, long lda,
                                        const u16* __restrict__ B, long ldb, int K, char* shm, bool pre, GA nx) {
  constexpr int TILE_B = 256 * 64 * 2, STAGE_B = 2 * TILE_B;
  int tid = threadIdx.x;
  asm volatile("" : "+v"(tid));
  const int wid = tid >> 6, lane = tid & 63, wr = wid >> 2, wc = wid & 3, fr = lane & 15, fq = lane >> 4;
  unsigned offA[4], offB[4];
#pragma unroll
  for (int i = 0; i < 4; ++i) {
    int R, C;
    stage_rc2(wid * 1024 + i * 8192 + lane * 16, R, C);
    offA[i] = (unsigned)(R * (int)lda + C);
    offB[i] = (unsigned)(R * (int)ldb + C);
  }
#define G256_STAGE(buf, kt)                                                                                         \
  do {                                                                                                              \
    _Pragma("unroll") for (int i = 0; i < 4; ++i) {                                                                 \
      __builtin_amdgcn_global_load_lds((const unsigned*)(A + offA[i] + (kt) * 64),                                  \
                                       (__attribute__((address_space(3))) unsigned*)(shm + (buf) * STAGE_B + wid * 1024 + i * 8192), 16, 0, 0); \
      __builtin_amdgcn_global_load_lds((const unsigned*)(B + offB[i] + (kt) * 64),                                  \
                                       (__attribute__((address_space(3))) unsigned*)(shm + (buf) * STAGE_B + TILE_B + wid * 1024 + i * 8192), 16, 0, 0); \
    }                                                                                                               \
  } while (0)
  const int nt = K >> 6;
  if (!pre) G256_STAGE(0, 0);
  asm volatile("s_waitcnt vmcnt(0)" ::: "memory");
  __syncthreads();
  for (int t = 0; t < nt; ++t) {
    const int cur = t & 1;
    if (t + 1 < nt) G256_STAGE(cur ^ 1, t + 1);
    const char* sa = shm + cur * STAGE_B;
    const char* sb = sa + TILE_B;
#pragma unroll
    for (int ks = 0; ks < 2; ++ks) {
      bf16x8 Bf[4];
#pragma unroll
      for (int n = 0; n < 4; ++n) Bf[n] = *(const bf16x8*)(sb + lds_byte2(wc * 64 + n * 16 + fr, ks * 32 + fq * 8));
#pragma unroll
      for (int mh = 0; mh < 2; ++mh) {
        bf16x8 At[4];
#pragma unroll
        for (int m = 0; m < 4; ++m) At[m] = *(const bf16x8*)(sa + lds_byte2(wr * 128 + (mh * 4 + m) * 16 + fr, ks * 32 + fq * 8));
#pragma unroll
        for (int m = 0; m < 4; ++m)
#pragma unroll
          for (int n = 0; n < 4; ++n) {
            if (SWAP) acc[mh * 4 + m][n] = MFMA(Bf[n], At[m], acc[mh * 4 + m][n]);
            else acc[mh * 4 + m][n] = MFMA(At[m], Bf[n], acc[mh * 4 + m][n]);
          }
      }
      __builtin_amdgcn_sched_group_barrier(0x100, 8, 0);
      __builtin_amdgcn_sched_group_barrier(0x008, 4, 0);
      __builtin_amdgcn_sched_group_barrier(0x100, 1, 0);
      __builtin_amdgcn_sched_group_barrier(0x008, 4, 0);
      __builtin_amdgcn_sched_group_barrier(0x100, 1, 0);
      __builtin_amdgcn_sched_group_barrier(0x008, 4, 0);
      __builtin_amdgcn_sched_group_barrier(0x100, 1, 0);
      __builtin_amdgcn_sched_group_barrier(0x008, 4, 0);
      __builtin_amdgcn_sched_group_barrier(0x100, 1, 0);
      __builtin_amdgcn_sched_group_barrier(0x008, 16, 0);
      __builtin_amdgcn_sched_barrier(0);
    }
    asm volatile("s_waitcnt vmcnt(0)" ::: "memory");
    __syncthreads();
  }
#undef G256_STAGE
  if (nx.A != nullptr) {
#pragma unroll
    for (int i = 0; i < 4; ++i) {
      int R, C;
      stage_rc2(wid * 1024 + i * 8192 + lane * 16, R, C);
      __builtin_amdgcn_global_load_lds((const unsigned*)(nx.A + (unsigned)(R * nx.lda + C)),
                                       (__attribute__((address_space(3))) unsigned*)(shm + wid * 1024 + i * 8192), 16, 0, 0);
      __builtin_amdgcn_global_load_lds((const unsigned*)(nx.B + (unsigned)(R * nx.ldb + C)),
                                       (__attribute__((address_space(3))) unsigned*)(shm + TILE_B + wid * 1024 + i * 8192), 16, 0, 0);
    }
  }
}

__device__ __forceinline__ void zero_acc(f32x4 (&acc)[8][4]) {
#pragma unroll
  for (int i = 0; i < 8; ++i)
#pragma unroll
    for (int j = 0; j < 4; ++j) acc[i][j] = f32x4{0.f, 0.f, 0.f, 0.f};
}

#define EPI_IDS int tid = threadIdx.x; asm volatile("" : "+v"(tid)); const int wid = tid >> 6, lane = tid & 63, wr = wid >> 2, wc = wid & 3, fr = lane & 15, fq = lane >> 4
__device__ __forceinline__ void tile_mn(int id, int NT, int& mt, int& nt) {
  const int G = 16;
  int grp = id / (G * NT), rem = id % (G * NT);
  nt = rem / G;
  mt = grp * G + (rem % G);
}

__device__ __forceinline__ void p0_transpose(const float* __restrict__ src, int K, int N, u16* __restrict__ dst, int tile, float* lds, int tid) {
  const int nk = K >> 6;
  const int tk = tile % nk, tn = tile / nk;
  const int k0 = tk * 64, n0 = tn * 64;
  {
    const int r0 = tid >> 4, c = (tid & 15) * 4;
    float4 v0 = *(const float4*)(src + (long)(k0 + r0) * N + n0 + c);
    float4 v1 = *(const float4*)(src + (long)(k0 + r0 + 16) * N + n0 + c);
    float4 v2 = *(const float4*)(src + (long)(k0 + r0 + 32) * N + n0 + c);
    float4 v3 = *(const float4*)(src + (long)(k0 + r0 + 48) * N + n0 + c);
    float* l0 = lds + r0 * 65 + c;
    l0[0] = v0.x; l0[1] = v0.y; l0[2] = v0.z; l0[3] = v0.w;
    l0[16 * 65 + 0] = v1.x; l0[16 * 65 + 1] = v1.y; l0[16 * 65 + 2] = v1.z; l0[16 * 65 + 3] = v1.w;
    l0[32 * 65 + 0] = v2.x; l0[32 * 65 + 1] = v2.y; l0[32 * 65 + 2] = v2.z; l0[32 * 65 + 3] = v2.w;
    l0[48 * 65 + 0] = v3.x; l0[48 * 65 + 1] = v3.y; l0[48 * 65 + 2] = v3.z; l0[48 * 65 + 3] = v3.w;
  }
  __syncthreads();
#pragma unroll 4
  for (int i = 0; i < 8; ++i) {
    int idx = tid + i * 256;
    int n = idx >> 5, kp = idx & 31;
    unsigned v = pack2(lds[(2 * kp) * 65 + n], lds[(2 * kp + 1) * 65 + n]);
    *(unsigned*)(dst + (long)(n0 + n) * K + k0 + 2 * kp) = v;
  }
  __syncthreads();
}

__device__ __forceinline__ void p0_adaln(const Params& p, int u, float* sl, int tid) {
  const int col0 = u * 32;
  for (int i = tid; i < 9 * 1024; i += 256) {
    int r = i >> 10, k = i & 1023;
    float v = (r < 8) ? p.c[r * 1024 + k] : p.c_ctx[k];
    sl[i] = v / (1.f + expf(-v));
  }
  __syncthreads();
  const int col = tid & 31, kg = tid >> 5;
  float acc[9];
#pragma unroll
  for (int r = 0; r < 9; ++r) acc[r] = 0.f;
#pragma unroll 4
  for (int k = kg * 128; k < kg * 128 + 128; ++k) {
    float wv = p.w_ada[(long)k * 6144 + col0 + col];
#pragma unroll
    for (int r = 0; r < 9; ++r) acc[r] += sl[r * 1024 + k] * wv;
  }
  float* red = sl + 9216;
#pragma unroll
  for (int r = 0; r < 9; ++r) red[(kg * 9 + r) * 32 + col] = acc[r];
  __syncthreads();
  for (int i = tid; i < 288; i += 256) {
    int r = i >> 5, cc = i & 31;
    float s = 0.f;
#pragma unroll
    for (int k2 = 0; k2 < 8; ++k2) s += red[(k2 * 9 + r) * 32 + cc];
    float* mod = (float*)(p.ws + OFF_MOD);
    mod[r * 6144 + col0 + cc] = s + p.b_ada[col0 + cc];
  }
  __syncthreads();
}

__device__ __forceinline__ void my_sincos(double x, double* s, double* c) {
  double kd = rint(x * 0.63661977236758134308);
  int k = (int)kd;
  double r = x - kd * 1.5707963267948966192;
  r -= kd * 6.123233995736766e-17;
  double r2 = r * r;
  double sp = r * (1.0 + r2 * (-1.0 / 6.0 + r2 * (1.0 / 120.0 + r2 * (-1.0 / 5040.0 + r2 * (1.0 / 362880.0 + r2 * (-1.0 / 39916800.0 + r2 * (1.0 / 6227020800.0 + r2 * (-1.0 / 1307674368000.0))))))));
  double cp = 1.0 + r2 * (-0.5 + r2 * (1.0 / 24.0 + r2 * (-1.0 / 720.0 + r2 * (1.0 / 40320.0 + r2 * (-1.0 / 3628800.0 + r2 * (1.0 / 479001600.0 + r2 * (-1.0 / 87178291200.0 + r2 * (1.0 / 20922789888000.0))))))));
  int q = k & 3;
  if (q == 0) { *s = sp; *c = cp; }
  else if (q == 1) { *s = cp; *c = -sp; }
  else if (q == 2) { *s = -sp; *c = -cp; }
  else { *s = -cp; *c = sp; }
}

__device__ __forceinline__ void p0_rope(const Params& p, int tid) {
  float* tab = (float*)(p.ws + OFF_ROPE);
  for (int e = tid * 8; e < tid * 8 + 8; ++e) {
    int pos = e >> 5, i = e & 31;
    double inv = exp(-(double)i * (9.210340371976184 / 32.0));
    float invf = (float)inv;
    float ang = (float)pos * invf;
    double s, c;
    my_sincos((double)ang, &s, &c);
    tab[e * 2] = (float)c;
    tab[e * 2 + 1] = (float)s;
  }
}

__device__ __forceinline__ void p0_unit(const Params& p, int u, char* smem, int tid) {
  float* lds = (float*)smem;
  if (u < 1664) { p0_transpose(p.w_in, 1024, 6656, (u16*)(p.ws + OFF_WIN), u, lds, tid); return; }
  u -= 1664;
  if (u < 128) { p0_transpose(p.w_pna, 512, 1024, (u16*)(p.ws + OFF_WPNA), u, lds, tid); return; }
  u -= 128;
  if (u < 256) { p0_transpose(p.w_pret, 1024, 1024, (u16*)(p.ws + OFF_WPRET), u, lds, tid); return; }
  u -= 256;
  if (u < 256) { p0_transpose(p.w_out, 1024, 1024, (u16*)(p.ws + OFF_WOUT), u, lds, tid); return; }
  u -= 256;
  if (u < 1408) { p0_transpose(p.w_up, 1024, 5632, (u16*)(p.ws + OFF_WUP), u, lds, tid); return; }
  u -= 1408;
  if (u < 704) { p0_transpose(p.w_down, 2816, 1024, (u16*)(p.ws + OFF_WDOWN), u, lds, tid); return; }
  u -= 704;
  if (u < 192) { p0_adaln(p, u, lds, tid); return; }
  p0_rope(p, tid);
}
constexpr int P0_UNITS = 1664 + 128 + 256 + 256 + 1408 + 704 + 192 + 1;

__device__ __forceinline__ float wave_sum(float v) {
#pragma unroll
  for (int o = 32; o >= 1; o >>= 1) v += __shfl_xor(v, o);
  return v;
}

__device__ __forceinline__ void rownorm2_bf16(const float* __restrict__ src, const float* __restrict__ gain,
                                              const float* __restrict__ shift, const float* __restrict__ scale,
                                              u16* __restrict__ dst) {
  const int lane = threadIdx.x & 63;
  float4 v[2][4];
#pragma unroll
  for (int r = 0; r < 2; ++r)
#pragma unroll
    for (int i = 0; i < 4; ++i) {
      const f32x4 t4 = __builtin_nontemporal_load((const f32x4*)(src + r * 1024) + lane + i * 64);
      v[r][i].x = t4[0]; v[r][i].y = t4[1]; v[r][i].z = t4[2]; v[r][i].w = t4[3];
    }
  float ss0 = 0.f, ss1 = 0.f;
#pragma unroll
  for (int i = 0; i < 4; ++i) {
    ss0 += v[0][i].x * v[0][i].x + v[0][i].y * v[0][i].y + v[0][i].z * v[0][i].z + v[0][i].w * v[0][i].w;
    ss1 += v[1][i].x * v[1][i].x + v[1][i].y * v[1][i].y + v[1][i].z * v[1][i].z + v[1][i].w * v[1][i].w;
  }
  ss0 = wave_sum(ss0);
  ss1 = wave_sum(ss1);
  const float r0 = rsqrtf(ss0 * (1.f / 1024.f) + 1e-6f), r1 = rsqrtf(ss1 * (1.f / 1024.f) + 1e-6f);
#pragma unroll
  for (int i = 0; i < 4; ++i) {
    const int c4 = lane + i * 64;
    float4 gn = ((const float4*)gain)[c4];
    float4 sh = ((const float4*)shift)[c4];
    float4 sc = ((const float4*)scale)[c4];
    *(u32x2*)(dst + c4 * 4) = pack4((v[0][i].x * r0 * gn.x) * (1.f + sc.x) + sh.x, (v[0][i].y * r0 * gn.y) * (1.f + sc.y) + sh.y,
                                    (v[0][i].z * r0 * gn.z) * (1.f + sc.z) + sh.z, (v[0][i].w * r0 * gn.w) * (1.f + sc.w) + sh.w);
    *(u32x2*)(dst + 1024 + c4 * 4) = pack4((v[1][i].x * r1 * gn.x) * (1.f + sc.x) + sh.x, (v[1][i].y * r1 * gn.y) * (1.f + sc.y) + sh.y,
                                           (v[1][i].z * r1 * gn.z) * (1.f + sc.z) + sh.z, (v[1][i].w * r1 * gn.w) * (1.f + sc.w) + sh.w);
  }
}


constexpr int WST_OFF = 65536;
constexpr int WST_BYTES = 9216;
constexpr int ZTAB_OFF = WST_OFF + 8 * WST_BYTES;

__device__ __forceinline__ void wave_store_nat_bf16(const f32x4 (&acc)[8][4], char* smem, u16* dst, long ld, float mul,
                                                    int wid, int lane, int fr, int fq) {
  u16* st = (u16*)(smem + WST_OFF + wid * WST_BYTES);
#pragma unroll
  for (int ps = 0; ps < 2; ++ps) {
#pragma unroll
    for (int m4 = 0; m4 < 4; ++m4)
#pragma unroll
      for (int n = 0; n < 4; ++n)
        *(u32x2*)(st + (m4 * 16 + fr) * 72 + n * 16 + fq * 4) =
            pack4(acc[ps * 4 + m4][n][0] * mul, acc[ps * 4 + m4][n][1] * mul, acc[ps * 4 + m4][n][2] * mul, acc[ps * 4 + m4][n][3] * mul);
#pragma unroll
    for (int i = 0; i < 8; ++i) {
      int id = lane + i * 64;
      int rl = id >> 3, c8 = (id & 7) * 8;
      __builtin_nontemporal_store(*(const u32x4*)(st + rl * 72 + c8), (u32x4*)(dst + (long)(ps * 64 + rl) * ld + c8));
    }
  }
}
__device__ __forceinline__ void wave_stage_tr(const f32x4 (&acc)[8][4], u16* st, int ps, float mul, int fr, int fq) {
#pragma unroll
  for (int nl = 0; nl < 2; ++nl)
#pragma unroll
    for (int m = 0; m < 8; ++m)
      *(u32x2*)(st + (nl * 16 + fr) * 136 + m * 16 + fq * 4) =
          pack4(acc[m][ps * 2 + nl][0] * mul, acc[m][ps * 2 + nl][1] * mul, acc[m][ps * 2 + nl][2] * mul, acc[m][ps * 2 + nl][3] * mul);
}
__device__ __forceinline__ void wave_store_tr_bf16(const f32x4 (&acc)[8][4], char* smem, u16* dstT, long tstride,
                                                   int wid, int lane, int fr, int fq) {
  u16* st = (u16*)(smem + WST_OFF + wid * WST_BYTES);
#pragma unroll
  for (int ps = 0; ps < 2; ++ps) {
    wave_stage_tr(acc, st, ps, 1.f, fr, fq);
#pragma unroll
    for (int i = 0; i < 8; ++i) {
      int id = lane + i * 64;
      int cl = id >> 4, r8 = (id & 15) * 8;
      __builtin_nontemporal_store(*(const u32x4*)(st + cl * 136 + r8), (u32x4*)(dstT + (long)(ps * 32 + cl) * tstride + r8));
    }
  }
}

template <int KIND>
__device__ __forceinline__ void inproj_kind(const Params& p, bool isctx, int m0, int nt256, char* smem, bool pre, GA nx) {
  const u16* A = (const u16*)(p.ws + OFF_HX) + (long)((isctx ? T : 0) + m0) * 1024;
  const u16* Bt = (const u16*)(p.ws + OFF_WIN) + (long)nt256 * 256 * 1024;
  const int seg = nt256 >> 1;
  const float2* rope = (const float2*)(p.ws + OFF_ROPE);
  f32x4 acc[8][4];
  zero_acc(acc);
  if (KIND == 0 || KIND == 1) {
    gemm256<true>(acc, A, 1024, Bt, 1024, 1024, smem, pre, nx);
    EPI_IDS;
    if (KIND == 1) {
#pragma unroll
      for (int m = 0; m < 8; ++m) {
        int n_ = (m0 + wr * 128 + m * 16 + fr) & 4095;
        int pos = ((wc & 1) == 0) ? (n_ >> 6) : (n_ & 63);
        const float2* rp = rope + pos * 32 + fq * 4;
#pragma unroll
        for (int nt = 0; nt < 2; ++nt) {
          float4 c01 = *(const float4*)(rp + nt * 16);
          float4 c23 = *(const float4*)(rp + nt * 16 + 2);
          float cs_[4] = {c01.x, c01.z, c23.x, c23.z}, sn_[4] = {c01.y, c01.w, c23.y, c23.w};
#pragma unroll
          for (int j = 0; j < 4; ++j) {
            float lo = acc[m][nt][j], hi = acc[m][nt + 2][j];
            acc[m][nt][j] = lo * cs_[j] - hi * sn_[j];
            acc[m][nt + 2][j] = lo * sn_[j] + hi * cs_[j];
          }
        }
      }
    }
    u16* dst; int ld; int cbase; float mul = 1.f;
    if (KIND == 1) { dst = (u16*)(p.ws + OFF_RQ); ld = 512; cbase = nt256 * 256 - 1536; }
    else if (seg == 0) { dst = (u16*)(p.ws + OFF_NAQ); ld = 512; cbase = nt256 * 256; mul = 0.125f * 1.4426950408889634f; }
    else if (seg == 1) { dst = isctx ? (u16*)(p.ws + OFF_CNAK) : (u16*)(p.ws + OFF_NAK); ld = 512; cbase = nt256 * 256 - 512; }
    else { dst = (u16*)(p.ws + OFF_RG); ld = 1024; cbase = nt256 * 256 - 3584; }
    wave_store_nat_bf16(acc, smem, dst + (long)(m0 + wr * 128) * ld + cbase + wc * 64, ld, mul, wid, lane, fr, fq);
  } else {
    if (KIND == 3) {
      float* ztw = (float*)(smem + ZTAB_OFF);
      const int t_ = threadIdx.x;
      __syncthreads();
      if (t_ < 256) {
        int hh = (nt256 & 1) * 2 + (t_ >> 7), mm = t_ & 127;
        ztw[t_] = expf(p.ldf[hh] * (float)(127 - mm));
        ztw[256 + t_] = expf(p.ldb[hh] * (float)mm);
      }
    }
    gemm256<false>(acc, A, 1024, Bt, 1024, 1024, smem, pre, nx);
    EPI_IDS;
    const int bb = isctx ? (m0 >> 8) : (m0 >> 12);
    const int nbase = isctx ? 0 : (m0 & 4095);
    const long tstride = isctx ? 256 : 4096;
    if (KIND == 2) {
      u16* dst; int cg0; long bstride;
      if (seg == 2) { dst = isctx ? (u16*)(p.ws + OFF_CNAVT) : (u16*)(p.ws + OFF_NAVT); cg0 = nt256 * 256 - 1024; bstride = 512; }
      else { dst = isctx ? (u16*)(p.ws + OFF_CRVT) : (u16*)(p.ws + OFF_RVT); cg0 = nt256 * 256 - 2560; bstride = 1024; }
      wave_store_tr_bf16(acc, smem, dst + ((long)bb * bstride + cg0 + wc * 64) * tstride + nbase + wr * 128, tstride, wid, lane, fr, fq);
    } else {
      const int h = (nt256 & 1) * 2 + (wc >> 1);
      const float rks = 0.08838834764831845f;
      const float* ztab = (const float*)(smem + ZTAB_OFF);
      if (!isctx) {
#pragma unroll
        for (int m = 0; m < 8; ++m) {
#pragma unroll
          for (int j = 0; j < 4; ++j) {
            int n_ = (m0 + wr * 128 + m * 16 + fq * 4 + j) & 4095;
            int pos = ((wc & 1) == 0) ? (n_ >> 6) : (n_ & 63);
#pragma unroll
            for (int nt = 0; nt < 2; ++nt) {
              float2 cs = rope[pos * 32 + nt * 16 + fr];
              float lo = acc[m][nt][j], hi = acc[m][nt + 2][j];
              acc[m][nt][j] = lo * cs.x - hi * cs.y;
              acc[m][nt + 2][j] = lo * cs.y + hi * cs.x;
            }
          }
        }
      }
      u16* rk = (u16*)(p.ws + OFF_RK);
      u16* ktf = isctx ? (u16*)(p.ws + OFF_CKTF) : (u16*)(p.ws + OFF_KTF);
      u16* ktb = isctx ? (u16*)(p.ws + OFF_CKTB) : (u16*)(p.ws + OFF_KTB);
      u16* st = (u16*)(smem + WST_OFF + wid * WST_BYTES);
      const float* zfh = ztab + (wc >> 1) * 128;
      const float* zbh = ztab + 256 + (wc >> 1) * 128;
      const int dkb = (wc & 1) * 64;
#pragma unroll
      for (int ps = 0; ps < 2; ++ps) {
        wave_stage_tr(acc, st, ps, rks, fr, fq);
#pragma unroll
        for (int i = 0; i < 8; ++i) {
          int id = lane + i * 64;
          int cl = id >> 4, r8 = (id & 15) * 8;
          u32x4 v = *(const u32x4*)(st + cl * 136 + r8);
          float4 zf0 = *(const float4*)(zfh + r8), zf1 = *(const float4*)(zfh + r8 + 4);
          float4 zb0 = *(const float4*)(zbh + r8), zb1 = *(const float4*)(zbh + r8 + 4);
          float e0 = bf2f((u16)(v[0] & 0xffffu)), e1 = bf2f((u16)(v[0] >> 16)), e2 = bf2f((u16)(v[1] & 0xffffu)), e3 = bf2f((u16)(v[1] >> 16));
          float e4 = bf2f((u16)(v[2] & 0xffffu)), e5 = bf2f((u16)(v[2] >> 16)), e6 = bf2f((u16)(v[3] & 0xffffu)), e7 = bf2f((u16)(v[3] >> 16));
          long tb = ((long)(bb * 4 + h) * 128 + dkb + ps * 32 + cl) * tstride + nbase + wr * 128 + r8;
          u32x4 of = {pack2(e0 * zf0.x, e1 * zf0.y), pack2(e2 * zf0.z, e3 * zf0.w), pack2(e4 * zf1.x, e5 * zf1.y), pack2(e6 * zf1.z, e7 * zf1.w)};
          u32x4 ob = {pack2(e0 * zb0.x, e1 * zb0.y), pack2(e2 * zb0.z, e3 * zb0.w), pack2(e4 * zb1.x, e5 * zb1.y), pack2(e6 * zb1.z, e7 * zb1.w)};
          *(u32x4*)(ktf + tb) = of;
          *(u32x4*)(ktb + tb) = ob;
        }
        if (!isctx) {
#pragma unroll
          for (int i = 0; i < 8; ++i) {
            int id = lane + i * 64;
            int row = id >> 2, c8 = (id & 3) * 8;
            const u16* sp = st + c8 * 136 + row;
            u32x4 o = {(unsigned)sp[0] | ((unsigned)sp[136] << 16), (unsigned)sp[2 * 136] | ((unsigned)sp[3 * 136] << 16),
                       (unsigned)sp[4 * 136] | ((unsigned)sp[5 * 136] << 16), (unsigned)sp[6 * 136] | ((unsigned)sp[7 * 136] << 16)};
            *(u32x4*)(rk + (long)(m0 + wr * 128 + row) * 512 + h * 128 + dkb + ps * 32 + c8) = o;
          }
        }
      }
    }
  }
}

__device__ __forceinline__ void inproj_decode(int id, bool& isctx, int& m0, int& nt256) {
  int mt_;
  if (id < 2304) { isctx = false; tile_mn(id, 18, mt_, nt256); }
  else {
    isctx = true;
    int id2 = id - 2304;
    mt_ = id2 & 7;
    int j = id2 >> 3;
    nt256 = (j < 4) ? (2 + j) : ((j < 6) ? (8 + (j - 4)) : (10 + (j - 6)));
  }
  m0 = mt_ * 256;
}
__device__ __forceinline__ GA inproj_ga(const Params& p, int id) {
  GA g; g.A = nullptr; g.B = nullptr; g.lda = 1024; g.ldb = 1024;
  if (id < 2304 + 80) {
    bool isctx; int m0, nt256;
    inproj_decode(id, isctx, m0, nt256);
    g.A = (const u16*)(p.ws + OFF_HX) + (long)((isctx ? T : 0) + m0) * 1024;
    g.B = (const u16*)(p.ws + OFF_WIN) + (long)nt256 * 256 * 1024;
  }
  return g;
}
__device__ __forceinline__ void inproj_tile(const Params& p, int id, char* smem, bool pre, GA nx) {
  bool isctx;
  int m0, nt256;
  inproj_decode(id, isctx, m0, nt256);
  const int seg = nt256 >> 1;
  if (seg == 3) inproj_kind<1>(p, isctx, m0, nt256, smem, pre, nx);
  else if (seg == 4) inproj_kind<3>(p, isctx, m0, nt256, smem, pre, nx);
  else if (seg == 2 || seg == 5 || seg == 6) inproj_kind<2>(p, isctx, m0, nt256, smem, pre, nx);
  else inproj_kind<0>(p, isctx, m0, nt256, smem, pre, nx);
}

struct NaRegs { u32x4 k0, k1, k2, k3, v0, v1, v2, v3, q0, q1; };

__device__ __forceinline__ void na_issue(const Params& p, int u, int chunk, int tid, NaRegs& R) {
  const int r = u & 63, head = (u >> 6) & 7, b = u >> 9;
  const int rs = min(max(r - 4, 0), 56);
  const int krow = tid >> 3, kcc = (tid & 7) * 8;
  const int vrow = tid >> 4, vcc = (tid & 15) * 8;
  const u16* kb; long ks_; const u16* vb; long vs_;
  if (chunk < 4) {
    kb = (const u16*)(p.ws + OFF_NAK) + (long)(b * 4096 + rs * 64 + chunk * 128 + krow) * 512 + head * 64 + kcc; ks_ = 32L * 512;
    vb = (const u16*)(p.ws + OFF_NAVT) + ((long)((b * 8 + head) * 64 + vrow)) * 4096 + rs * 64 + chunk * 128 + vcc; vs_ = 16L * 4096;
  } else {
    kb = (const u16*)(p.ws + OFF_CNAK) + (long)(b * 256 + (chunk - 4) * 128 + krow) * 512 + head * 64 + kcc; ks_ = 32L * 512;
    vb = (const u16*)(p.ws + OFF_CNAVT) + ((long)((b * 8 + head) * 64 + vrow)) * 256 + (chunk - 4) * 128 + vcc; vs_ = 16L * 256;
  }
  R.k0 = *(const u32x4*)(kb); R.k1 = *(const u32x4*)(kb + ks_); R.k2 = *(const u32x4*)(kb + 2 * ks_); R.k3 = *(const u32x4*)(kb + 3 * ks_);
  R.v0 = *(const u32x4*)(vb); R.v1 = *(const u32x4*)(vb + vs_); R.v2 = *(const u32x4*)(vb + 2 * vs_); R.v3 = *(const u32x4*)(vb + 3 * vs_);
  if (chunk == 0) {
    const u16* qb = (const u16*)(p.ws + OFF_NAQ) + (long)(b * 4096 + r * 64 + krow) * 512 + head * 64 + kcc;
    R.q0 = *(const u32x4*)(qb);
    R.q1 = *(const u32x4*)(qb + 32L * 512);
  }
}

__device__ __forceinline__ void na_run(const Params& p, int first, int stride, int count, char* smem, int tid) {
  u16* Qs = (u16*)smem;
  u16* Ks = Qs + 64 * 72;
  u16* Vt = Ks + 128 * 72;
  float* bias = (float*)(Vt + 64 * 136);
  const int lane = tid & 63, w = tid >> 6, l15 = lane & 15, g = lane >> 4;
  const int krow = tid >> 3, kcc = (tid & 7) * 8, vrow = tid >> 4, vcc = (tid & 15) * 8;
  const int qc = w * 16 + l15;
  const int cs = min(max(qc - 8, 0), 48);
  const int cw = min(max(16 * w - 8, 0), 32);
  int dco[2][4];
  unsigned okm = 0u;
#pragma unroll
  for (int tt = 0; tt < 2; ++tt)
#pragma unroll
    for (int j = 0; j < 4; ++j) {
      int kc = cw + tt * 16 + g * 4 + j;
      if ((kc >= cs) && (kc < cs + 16)) okm |= 1u << (tt * 4 + j);
      dco[tt][j] = min(max(kc - qc + 15, 0), 30);
    }
  NaRegs R;
  if (count > 0) na_issue(p, first, 0, tid, R);
  for (int k = 0; k < count; ++k) {
    const int u = first + k * stride;
    const int r = u & 63, head = (u >> 6) & 7, b = u >> 9;
    const int rs = min(max(r - 4, 0), 56);
    f32x4 O[4];
#pragma unroll
    for (int i = 0; i < 4; ++i) O[i] = f32x4{0.f, 0.f, 0.f, 0.f};
    float m_run = -1e30f, l_run = 0.f;
    bf16x8 qf[2];
    for (int chunk = 0; chunk < 6; ++chunk) {
      __syncthreads();
      *(u32x4*)(Ks + krow * 72 + kcc) = R.k0; *(u32x4*)(Ks + (krow + 32) * 72 + kcc) = R.k1;
      *(u32x4*)(Ks + (krow + 64) * 72 + kcc) = R.k2; *(u32x4*)(Ks + (krow + 96) * 72 + kcc) = R.k3;
      *(u32x4*)(Vt + vrow * 136 + vcc) = R.v0; *(u32x4*)(Vt + (vrow + 16) * 136 + vcc) = R.v1;
      *(u32x4*)(Vt + (vrow + 32) * 136 + vcc) = R.v2; *(u32x4*)(Vt + (vrow + 48) * 136 + vcc) = R.v3;
      if (chunk == 0) {
        *(u32x4*)(Qs + krow * 72 + kcc) = R.q0; *(u32x4*)(Qs + (krow + 32) * 72 + kcc) = R.q1;
        for (int i = tid; i < 465; i += 256) bias[i] = p.na_rpb[head * 465 + i] * 1.4426950408889634f;
      }
      __syncthreads();
      if (chunk < 5) na_issue(p, u, chunk + 1, tid, R);
      else if (k + 1 < count) na_issue(p, u + stride, 0, tid, R);
      if (chunk == 0) {
        qf[0] = *(const bf16x8*)(Qs + (w * 16 + l15) * 72 + g * 8);
        qf[1] = *(const bf16x8*)(Qs + (w * 16 + l15) * 72 + 32 + g * 8);
      }
#pragma unroll
      for (int kg = 0; kg < 4; ++kg) {
        if (chunk < 4 && kg >= 2) continue;
        const int kb = (chunk < 4) ? (kg * 64 + cw) : (kg * 32);
        const int boff = (rs - r + 7 + chunk * 2 + kg) * 31;
        f32x4 s[2];
#pragma unroll
        for (int tt = 0; tt < 2; ++tt) {
          s[tt] = f32x4{0.f, 0.f, 0.f, 0.f};
#pragma unroll
          for (int ks = 0; ks < 2; ++ks) {
            bf16x8 a = *(const bf16x8*)(Ks + (kb + tt * 16 + l15) * 72 + ks * 32 + g * 8);
            s[tt] = MFMA(a, qf[ks], s[tt]);
          }
        }
        float mx = -1e30f;
#pragma unroll
        for (int tt = 0; tt < 2; ++tt)
#pragma unroll
          for (int j = 0; j < 4; ++j) {
            float v = s[tt][j];
            if (chunk < 4) {
              const bool ok = (okm >> (tt * 4 + j)) & 1u;
              v = ok ? (v + bias[boff + dco[tt][j]]) : -1e30f;
            }
            s[tt][j] = v;
            mx = fmaxf(mx, v);
          }
        mx = fmaxf(mx, __shfl_xor(mx, 16));
        mx = fmaxf(mx, __shfl_xor(mx, 32));
        const float m_new = fmaxf(m_run, mx);
        const float sc = __builtin_amdgcn_exp2f(m_run - m_new);
        m_run = m_new;
        float ps = 0.f;
#pragma unroll
        for (int tt = 0; tt < 2; ++tt)
#pragma unroll
          for (int j = 0; j < 4; ++j) {
            float v = s[tt][j];
            float pv = (v > -1e29f) ? __builtin_amdgcn_exp2f(v - m_new) : 0.f;
            s[tt][j] = pv;
            ps += pv;
          }
        l_run = l_run * sc + ps;
#pragma unroll
        for (int mt = 0; mt < 4; ++mt) O[mt] *= sc;
        u32x2 p0 = pack4(s[0][0], s[0][1], s[0][2], s[0][3]);
        u32x2 p1 = pack4(s[1][0], s[1][1], s[1][2], s[1][3]);
        u32x4 pb = {p0.x, p0.y, p1.x, p1.y};
        bf16x8 bfr = __builtin_bit_cast(bf16x8, pb);
#pragma unroll
        for (int mt = 0; mt < 4; ++mt) {
          const u16* vp = Vt + (mt * 16 + l15) * 136 + kb + g * 4;
          u32x2 a0 = *(const u32x2*)vp;
          u32x2 a1 = *(const u32x2*)(vp + 16);
          u32x4 ab = {a0.x, a0.y, a1.x, a1.y};
          O[mt] = MFMA(__builtin_bit_cast(bf16x8, ab), bfr, O[mt]);
        }
      }
    }
    l_run += __shfl_xor(l_run, 16);
    l_run += __shfl_xor(l_run, 32);
    const float inv = 1.f / l_run;
    u16* o = (u16*)(p.ws + OFF_NAQ) + (long)(b * 4096 + r * 64 + qc) * 512 + head * 64 + g * 4;
#pragma unroll
    for (int mt = 0; mt < 4; ++mt)
      *(u32x2*)(o + mt * 16) = pack4(O[mt][0] * inv, O[mt][1] * inv, O[mt][2] * inv, O[mt][3] * inv);
  }
}

struct ScanRegs { u32x4 k0, k1, k2, k3, k4, k5, k6, k7, v0, v1, v2, v3; };

__device__ __forceinline__ void scan_issue(const Params& p, int b, int h, int dir, int s, int step, int tid, ScanRegs& R) {
  const bool isctx = step < 2;
  const int c = isctx ? (dir ? 1 - step : step) : (dir ? 31 - (step - 2) : step - 2);
  const int row = tid >> 4, cc = (tid & 15) * 8;
  const u16* kb; const u16* vb; long st;
  if (isctx) {
    kb = (const u16*)(p.ws + (dir ? OFF_CKTB : OFF_CKTF)) + ((long)((b * 4 + h) * 128 + row)) * 256 + c * 128 + cc;
    vb = (const u16*)(p.ws + OFF_CRVT) + ((long)((b * 4 + h) * 256 + s * 64 + row)) * 256 + c * 128 + cc;
    st = 16L * 256;
  } else {
    kb = (const u16*)(p.ws + (dir ? OFF_KTB : OFF_KTF)) + ((long)((b * 4 + h) * 128 + row)) * 4096 + c * 128 + cc;
    vb = (const u16*)(p.ws + OFF_RVT) + ((long)((b * 4 + h) * 256 + s * 64 + row)) * 4096 + c * 128 + cc;
    st = 16L * 4096;
  }
  R.k0 = *(const u32x4*)(kb); R.k1 = *(const u32x4*)(kb + st); R.k2 = *(const u32x4*)(kb + 2 * st); R.k3 = *(const u32x4*)(kb + 3 * st);
  R.k4 = *(const u32x4*)(kb + 4 * st); R.k5 = *(const u32x4*)(kb + 5 * st); R.k6 = *(const u32x4*)(kb + 6 * st); R.k7 = *(const u32x4*)(kb + 7 * st);
  R.v0 = *(const u32x4*)(vb); R.v1 = *(const u32x4*)(vb + st); R.v2 = *(const u32x4*)(vb + 2 * st); R.v3 = *(const u32x4*)(vb + 3 * st);
}

__device__ __forceinline__ void scan_step(const Params& p, ScanRegs& R, f32x4 (&S)[8], int b, int h, int dir, int s, int step,
                                          float gL, u16* Kt, u16* Vs, int tid) {
  const int lane = tid & 63, w = tid >> 6, l15 = lane & 15, g = lane >> 4;
  const int row = tid >> 4, cc = (tid & 15) * 8;
  const bool isctx = step < 2;
  const int c = isctx ? (dir ? 1 - step : step) : (dir ? 31 - (step - 2) : step - 2);
  if (!isctx) {
    u16* dst = (u16*)p.out + ((((long)(b * 4 + h) * 32 + c) * 2 + dir) * 32768L) + (long)(s * 64 + w * 16 + l15) * 128 + g * 4;
#pragma unroll
    for (int i = 0; i < 8; ++i) *(u32x2*)(dst + i * 16) = pack4(S[i][0], S[i][1], S[i][2], S[i][3]);
  }
  *(u32x4*)(Kt + row * 136 + cc) = R.k0; *(u32x4*)(Kt + (row + 16) * 136 + cc) = R.k1;
  *(u32x4*)(Kt + (row + 32) * 136 + cc) = R.k2; *(u32x4*)(Kt + (row + 48) * 136 + cc) = R.k3;
  *(u32x4*)(Kt + (row + 64) * 136 + cc) = R.k4; *(u32x4*)(Kt + (row + 80) * 136 + cc) = R.k5;
  *(u32x4*)(Kt + (row + 96) * 136 + cc) = R.k6; *(u32x4*)(Kt + (row + 112) * 136 + cc) = R.k7;
  *(u32x4*)(Vs + row * 136 + cc) = R.v0; *(u32x4*)(Vs + (row + 16) * 136 + cc) = R.v1;
  *(u32x4*)(Vs + (row + 32) * 136 + cc) = R.v2; *(u32x4*)(Vs + (row + 48) * 136 + cc) = R.v3;
  if (step + 2 < 34) scan_issue(p, b, h, dir, s, step + 2, tid, R);
  __syncthreads();
#pragma unroll
  for (int i = 0; i < 8; ++i) S[i] *= gL;
#pragma unroll
  for (int ks = 0; ks < 4; ++ks) {
    bf16x8 bfr = *(const bf16x8*)(Vs + (w * 16 + l15) * 136 + ks * 32 + g * 8);
#pragma unroll
    for (int i = 0; i < 8; ++i) {
      bf16x8 a = *(const bf16x8*)(Kt + (i * 16 + l15) * 136 + ks * 32 + g * 8);
      S[i] = MFMA(a, bfr, S[i]);
    }
  }
}

__device__ __forceinline__ void scan_unit(const Params& p, int u, char* smem, int tid) {
  const int s = u & 3, dir = (u >> 2) & 1, h = (u >> 3) & 3, b = u >> 5;
  u16* Kt = (u16*)smem;
  u16* Vs = Kt + 128 * 136;
  const float lg = dir ? p.ldb[h] : p.ldf[h];
  const float gL = expf(lg * 128.f);
  f32x4 S[8];
#pragma unroll
  for (int i = 0; i < 8; ++i) S[i] = f32x4{0.f, 0.f, 0.f, 0.f};
  ScanRegs RA, RB;
  scan_issue(p, b, h, dir, s, 0, tid, RA);
  scan_issue(p, b, h, dir, s, 1, tid, RB);
#pragma unroll 1
  for (int sp = 0; sp < 17; ++sp) {
    const int step = 2 * sp;
    __syncthreads();
    scan_step(p, RA, S, b, h, dir, s, step, gL, Kt, Vs, tid);
    __syncthreads();
    scan_step(p, RB, S, b, h, dir, s, step + 1, gL, Kt, Vs, tid);
  }
}

__device__ __forceinline__ void stage_q_scaled(u16* Qs, const u16* rq, long t0, int h, const float* tab, int mode, int tid) {
#pragma unroll
  for (int i = 0; i < 8; ++i) {
    int idx = tid + i * 256;
    int row = idx >> 4, cc = (idx & 15) * 8;
    u32x4 v = *(const u32x4*)(rq + (t0 + row) * 512 + h * 128 + cc);
    if (mode != 0) {
      float sc = (mode == 1) ? tab[row + 1] : tab[128 - row];
#pragma unroll
      for (int q = 0; q < 4; ++q) {
        float a = bf2f((u16)(v[q] & 0xffffu)) * sc;
        float bq = bf2f((u16)(v[q] >> 16)) * sc;
        v[q] = pack2(a, bq);
      }
    }
    *(u32x4*)(Qs + row * 136 + cc) = v;
  }
}

__device__ __forceinline__ void rescale_q_inplace(u16* Qs, const float* tF, const float* tFi, const float* tB, int mode, int tid) {
#pragma unroll
  for (int i = 0; i < 8; ++i) {
    int idx = tid + i * 256;
    int row = idx >> 4, cc = (idx & 15) * 8;
    u32x4 v = *(const u32x4*)(Qs + row * 136 + cc);
    const float sc = (mode == 1) ? tF[row + 1] : tB[128 - row] * tFi[row + 1];
#pragma unroll
    for (int q = 0; q < 4; ++q) {
      float a = bf2f((u16)(v[q] & 0xffffu)) * sc;
      float bq = bf2f((u16)(v[q] >> 16)) * sc;
      v[q] = pack2(a, bq);
    }
    *(u32x4*)(Qs + row * 136 + cc) = v;
  }
}

__device__ __forceinline__ void intra_unit(const Params& p, int u, char* smem, int tid) {
  const int c = u & 31, h = (u >> 5) & 3, b = u >> 7;
  u16* Qs = (u16*)smem;
  u16* Ks = Qs + 128 * 136;
  const int lane = tid & 63, w = tid >> 6, l15 = lane & 15, g = lane >> 4;
  const long t0 = (long)b * 4096 + c * 128;
  const u16* rq = (const u16*)(p.ws + OFF_RQ);
  const u16* rk = (const u16*)(p.ws + OFF_RK);
  const u16* rvT = (const u16*)(p.ws + OFF_RVT);
  const u16* sbuf = (const u16*)p.out;
  u16* oraw = (u16*)(p.ws + OFF_ORAW);
  const float lgf = p.ldf[h], lgb = p.ldb[h];
  float* tF = (float*)(smem + 69632);
  float* tFi = tF + 132;
  float* tB = tFi + 132;
  float* tBi = tB + 132;
  __syncthreads();
  if (tid < 129) {
    tF[tid] = expf(lgf * (float)tid);
    tFi[tid] = expf(-lgf * (float)tid);
    tB[tid] = expf(lgb * (float)tid);
    tBi[tid] = expf(-lgb * (float)tid);
  }
  stage_q_scaled(Qs, rq, t0, h, nullptr, 0, tid);
#pragma unroll
  for (int i = 0; i < 8; ++i) {
    int idx = tid + i * 256;
    int row = idx >> 4, cc = (idx & 15) * 8;
    *(u32x4*)(Ks + row * 136 + cc) = *(const u32x4*)(rk + (t0 + row) * 512 + h * 128 + cc);
  }
  __syncthreads();
  {
    f32x4 P[2][8];
#pragma unroll
    for (int i = 0; i < 2; ++i)
#pragma unroll
      for (int j = 0; j < 8; ++j) P[i][j] = f32x4{0.f, 0.f, 0.f, 0.f};
#pragma unroll 1
    for (int ks = 0; ks < 4; ++ks) {
      bf16x8 a0 = *(const bf16x8*)(Qs + (32 * w + l15) * 136 + ks * 32 + g * 8);
      bf16x8 a1 = *(const bf16x8*)(Qs + (32 * w + 16 + l15) * 136 + ks * 32 + g * 8);
#pragma unroll
      for (int nt = 0; nt < 8; ++nt) {
        bf16x8 bb = *(const bf16x8*)(Ks + (nt * 16 + l15) * 136 + ks * 32 + g * 8);
        P[0][nt] = MFMA(a0, bb, P[0][nt]);
        P[1][nt] = MFMA(a1, bb, P[1][nt]);
      }
    }
    __syncthreads();
#pragma unroll
    for (int mt = 0; mt < 2; ++mt)
#pragma unroll
      for (int nt = 0; nt < 8; ++nt)
#pragma unroll
        for (int j = 0; j < 4; ++j) {
          int l = 32 * w + mt * 16 + g * 4 + j;
          int m = nt * 16 + l15;
          float d = (m <= l) ? tF[l] * tFi[m] : tB[m] * tBi[l];
          Ks[l * 136 + m] = f2bf(P[mt][nt][j] * d);
        }
  }
#pragma unroll 1
  for (int hf = 0; hf < 2; ++hf) {
    const int dvb = hf * 128 + w * 32;
    if (hf == 0) rescale_q_inplace(Qs, tF, tFi, tB, 1, tid);
    else stage_q_scaled(Qs, rq, t0, h, tF, 1, tid);
    __syncthreads();
    f32x4 O[8][2];
#pragma unroll
    for (int i = 0; i < 8; ++i) { O[i][0] = f32x4{0.f, 0.f, 0.f, 0.f}; O[i][1] = f32x4{0.f, 0.f, 0.f, 0.f}; }
    {
      const u16* vb = rvT + ((long)((b * 4 + h) * 256 + dvb + l15)) * 4096 + c * 128 + g * 8;
#pragma unroll
      for (int ks = 0; ks < 4; ++ks) {
        bf16x8 bf0 = *(const bf16x8*)(vb + ks * 32);
        bf16x8 bf1 = *(const bf16x8*)(vb + 16L * 4096 + ks * 32);
#pragma unroll
        for (int mt = 0; mt < 8; ++mt) {
          bf16x8 a = *(const bf16x8*)(Ks + (mt * 16 + l15) * 136 + ks * 32 + g * 8);
          O[mt][0] = MFMA(a, bf0, O[mt][0]);
          O[mt][1] = MFMA(a, bf1, O[mt][1]);
        }
      }
    }
    {
      const u16* sb = sbuf + ((((long)(b * 4 + h) * 32 + c) * 2 + 0) * 32768L) + (long)(dvb + l15) * 128 + g * 8;
#pragma unroll
      for (int ks = 0; ks < 4; ++ks) {
        bf16x8 bf0 = *(const bf16x8*)(sb + ks * 32);
        bf16x8 bf1 = *(const bf16x8*)(sb + 16 * 128 + ks * 32);
#pragma unroll
        for (int mt = 0; mt < 8; ++mt) {
          bf16x8 a = *(const bf16x8*)(Qs + (mt * 16 + l15) * 136 + ks * 32 + g * 8);
          O[mt][0] = MFMA(a, bf0, O[mt][0]);
          O[mt][1] = MFMA(a, bf1, O[mt][1]);
        }
      }
    }
    __syncthreads();
    rescale_q_inplace(Qs, tF, tFi, tB, 2, tid);
    __syncthreads();
    {
      const u16* sb = sbuf + ((((long)(b * 4 + h) * 32 + c) * 2 + 1) * 32768L) + (long)(dvb + l15) * 128 + g * 8;
#pragma unroll
      for (int ks = 0; ks < 4; ++ks) {
        bf16x8 bf0 = *(const bf16x8*)(sb + ks * 32);
        bf16x8 bf1 = *(const bf16x8*)(sb + 16 * 128 + ks * 32);
#pragma unroll
        for (int mt = 0; mt < 8; ++mt) {
          bf16x8 a = *(const bf16x8*)(Qs + (mt * 16 + l15) * 136 + ks * 32 + g * 8);
          O[mt][0] = MFMA(a, bf0, O[mt][0]);
          O[mt][1] = MFMA(a, bf1, O[mt][1]);
        }
      }
    }
    __syncthreads();
#pragma unroll
    for (int mt = 0; mt < 8; ++mt)
#pragma unroll
      for (int nt = 0; nt < 2; ++nt)
#pragma unroll
        for (int j = 0; j < 4; ++j) Qs[(mt * 16 + g * 4 + j) * 136 + w * 32 + nt * 16 + l15] = f2bf(O[mt][nt][j]);
    __syncthreads();
#pragma unroll
    for (int i = 0; i < 8; ++i) {
      int idx = tid + i * 256;
      int row = idx >> 4, cc = (idx & 15) * 8;
      *(u32x4*)(oraw + (t0 + row) * 1024 + h * 256 + hf * 128 + cc) = *(const u32x4*)(Qs + row * 136 + cc);
    }
    __syncthreads();
  }
  u16* rg = (u16*)(p.ws + OFF_RG);
#pragma unroll 1
  for (int rb = 0; rb < 4; ++rb) {
    u32x2 ovv[8], gvv[8];
#pragma unroll
    for (int r = 0; r < 8; ++r) {
      const long l = t0 + 32 * w + rb * 8 + r;
      ovv[r] = *(const u32x2*)(oraw + l * 1024 + h * 256 + lane * 4);
      gvv[r] = *(const u32x2*)(rg + l * 1024 + h * 256 + lane * 4);
    }
#pragma unroll
    for (int r = 0; r < 8; ++r) {
      const long l = t0 + 32 * w + rb * 8 + r;
      const u32x2 ov = ovv[r], gv = gvv[r];
      float x0 = bf2f((u16)(ov.x & 0xffffu)), x1 = bf2f((u16)(ov.x >> 16)), x2 = bf2f((u16)(ov.y & 0xffffu)), x3 = bf2f((u16)(ov.y >> 16));
      float mu = wave_sum(x0 + x1 + x2 + x3) * (1.f / 256.f);
      float d0 = x0 - mu, d1 = x1 - mu, d2 = x2 - mu, d3 = x3 - mu;
      float var = wave_sum(d0 * d0 + d1 * d1 + d2 * d2 + d3 * d3) * (1.f / 256.f);
      float rstd = rsqrtf(var + 1e-6f);
      float g0 = bf2f((u16)(gv.x & 0xffffu)), g1 = bf2f((u16)(gv.x >> 16)), g2 = bf2f((u16)(gv.y & 0xffffu)), g3 = bf2f((u16)(gv.y >> 16));
      *(u32x2*)(rg + l * 1024 + h * 256 + lane * 4) = pack4(d0 * rstd * siluf_(g0), d1 * rstd * siluf_(g1), d2 * rstd * siluf_(g2), d3 * rstd * siluf_(g3));
    }
  }
}

__device__ __forceinline__ GA merge_ga(const Params& p, int step, int m0, int n0) {
  GA g;
  if (step == 0)      { g.A = (const u16*)(p.ws + OFF_HX) + (long)m0 * 1024;  g.B = (const u16*)(p.ws + OFF_WIN) + (long)(4608 + n0) * 1024; g.lda = 1024; g.ldb = 1024; }
  else if (step == 1) { g.A = (const u16*)(p.ws + OFF_NAQ) + (long)m0 * 512;  g.B = (const u16*)(p.ws + OFF_WPNA) + (long)n0 * 512;          g.lda = 512;  g.ldb = 512; }
  else if (step == 2) { g.A = (const u16*)(p.ws + OFF_HX) + (long)m0 * 1024;  g.B = (const u16*)(p.ws + OFF_WIN) + (long)(5632 + n0) * 1024; g.lda = 1024; g.ldb = 1024; }
  else                { g.A = (const u16*)(p.ws + OFF_RG) + (long)m0 * 1024;  g.B = (const u16*)(p.ws + OFF_WPRET) + (long)n0 * 1024;        g.lda = 1024; g.ldb = 1024; }
  return g;
}
#define F32_EPILOGUE(BODY)                                                              \
  {                                                                                     \
    float* st_ = (float*)(smem + WST_OFF + wid * WST_BYTES);                            \
    _Pragma("unroll") for (int ps_ = 0; ps_ < 4; ++ps_) {                               \
      _Pragma("unroll") for (int m2_ = 0; m2_ < 2; ++m2_)                               \
        _Pragma("unroll") for (int n_ = 0; n_ < 4; ++n_)                                \
          *(f32x4*)(st_ + (m2_ * 16 + fr) * 68 + n_ * 16 + fq * 4) = acc[ps_ * 2 + m2_][n_]; \
      _Pragma("unroll") for (int i_ = 0; i_ < 8; ++i_) {                                \
        const int id_ = lane + i_ * 64;                                                 \
        const int rl_ = id_ >> 4, c4_ = (id_ & 15) * 4;                                 \
        const int rt = wr * 128 + ps_ * 32 + rl_, ct = wc * 64 + c4_;                   \
        const f32x4 a4 = *(const f32x4*)(st_ + rl_ * 68 + c4_);                         \
        BODY                                                                            \
      }                                                                                 \
    }                                                                                   \
  }

template <int STEP>
__device__ __forceinline__ void merge_step(const Params& p, int m0, int n0, char* smem, bool pre, GA nx) {
  EPI_IDS;
  u16* park1 = (u16*)p.out;
  u16* park2 = (u16*)(p.ws + OFF_PARK2);
  u16* merged = (u16*)(p.ws + OFF_MERGED);
  f32x4 acc[8][4];
  zero_acc(acc);
  {
    GA g = merge_ga(p, STEP, m0, n0);
    gemm256<true>(acc, g.A, g.lda, g.B, g.ldb, (STEP == 1) ? 512 : 1024, smem, pre, nx);
  }
  if (STEP == 0 || STEP == 2) {
    u16* dst = (STEP == 0) ? park1 : park2;
    F32_EPILOGUE({
      *(u32x2*)(dst + (long)(m0 + rt) * 1024 + n0 + ct) = pack4(sigmoidf_(a4[0]), sigmoidf_(a4[1]), sigmoidf_(a4[2]), sigmoidf_(a4[3]));
    })
  } else if (STEP == 1) {
    F32_EPILOGUE({
      u16* d = park1 + (long)(m0 + rt) * 1024 + n0 + ct;
      u32x2 g2 = *(const u32x2*)d;
      *(u32x2*)d = pack4(bf2f((u16)(g2.x & 0xffffu)) * a4[0], bf2f((u16)(g2.x >> 16)) * a4[1],
                         bf2f((u16)(g2.y & 0xffffu)) * a4[2], bf2f((u16)(g2.y >> 16)) * a4[3]);
    })
  } else {
    F32_EPILOGUE({
      const long off = (long)(m0 + rt) * 1024 + n0 + ct;
      u32x2 a = *(const u32x2*)(park1 + off);
      u32x2 gb = *(const u32x2*)(park2 + off);
      *(u32x2*)(merged + off) = pack4(bf2f((u16)(a.x & 0xffffu)) + bf2f((u16)(gb.x & 0xffffu)) * a4[0],
                                      bf2f((u16)(a.x >> 16)) + bf2f((u16)(gb.x >> 16)) * a4[1],
                                      bf2f((u16)(a.y & 0xffffu)) + bf2f((u16)(gb.y & 0xffffu)) * a4[2],
                                      bf2f((u16)(a.y >> 16)) + bf2f((u16)(gb.y >> 16)) * a4[3]);
    })
  }
  asm volatile("" ::: "memory");
}

__device__ __forceinline__ GA outproj_ga(const Params& p, int id) {
  GA g; g.A = nullptr; g.B = nullptr; g.lda = 1024; g.ldb = 1024;
  if (id < 512) {
    int mt_, nt_;
    tile_mn(id, 4, mt_, nt_);
    g.A = (const u16*)(p.ws + OFF_MERGED) + (long)mt_ * 256 * 1024;
    g.B = (const u16*)(p.ws + OFF_WOUT) + (long)nt_ * 256 * 1024;
  }
  return g;
}
__device__ __forceinline__ void outproj_tile(const Params& p, int id, char* smem, bool pre, GA nx) {
  int mt_, nt_;
  tile_mn(id, 4, mt_, nt_);
  const int m0 = mt_ * 256, n0 = nt_ * 256;
  EPI_IDS;
  f32x4 acc[8][4];
  zero_acc(acc);
  gemm256<true>(acc, (const u16*)(p.ws + OFF_MERGED) + (long)m0 * 1024, 1024, (const u16*)(p.ws + OFF_WOUT) + (long)n0 * 1024, 1024, 1024, smem, pre, nx);
  const float* mod = (const float*)(p.ws + OFF_MOD);
  const int bb = m0 >> 12;
  F32_EPILOGUE({
    const long off = (long)(m0 + rt) * 1024 + n0 + ct;
    const f32x4 xv = __builtin_nontemporal_load((const f32x4*)(p.x + off));
    float4 gv = *(const float4*)(mod + bb * 6144 + 2048 + n0 + ct);
    f32x4 o;
    o[0] = xv[0] + gv.x * a4[0];
    o[1] = xv[1] + gv.y * a4[1];
    o[2] = xv[2] + gv.z * a4[2];
    o[3] = xv[3] + gv.w * a4[3];
    __builtin_nontemporal_store(o, (f32x4*)(p.out + off));
  })
}

__device__ __forceinline__ int ffn_h(int half) { return half ? 1280 : 1536; }
__device__ __forceinline__ int ffn_a0(int half) { return half ? 1536 : 0; }

__device__ __forceinline__ GA up_ga(const Params& p, int half, int id) {
  const int H = ffn_h(half), a0 = ffn_a0(half), NT = 2 * H / 256, NA_ = H / 256;
  GA g; g.A = nullptr; g.B = nullptr; g.lda = 1024; g.ldb = 1024;
  if (id < 128 * NT) {
    int mt_, j;
    tile_mn(id, NT, mt_, j);
    const int wrow = (j < NA_) ? (a0 + j * 256) : (2816 + a0 + (j - NA_) * 256);
    g.A = (const u16*)(p.ws + OFF_HX) + (long)mt_ * 256 * 1024;
    g.B = (const u16*)(p.ws + OFF_WUP) + (long)wrow * 1024;
  }
  return g;
}
__device__ __forceinline__ void up_tile(const Params& p, int half, int id, char* smem, bool pre, GA nx) {
  const int H = ffn_h(half), a0 = ffn_a0(half), NT = 2 * H / 256, NA_ = H / 256;
  int mt_, j;
  tile_mn(id, NT, mt_, j);
  const int m0 = mt_ * 256;
  const int wrow = (j < NA_) ? (a0 + j * 256) : (2816 + a0 + (j - NA_) * 256);
  EPI_IDS;
  f32x4 acc[8][4];
  zero_acc(acc);
  gemm256<true>(acc, (const u16*)(p.ws + OFF_HX) + (long)m0 * 1024, 1024, (const u16*)(p.ws + OFF_WUP) + (long)wrow * 1024, 1024, 1024, smem, pre, nx);
  u16* uh = (u16*)(p.ws + OFF_UH);
  const long us = 2 * H;
  wave_store_nat_bf16(acc, smem, uh + (long)(m0 + wr * 128) * us + j * 256 + wc * 64, us, 1.f, wid, lane, fr, fq);
}

__device__ __forceinline__ void act_unit(const Params& p, int half, int u, int tid) {
  const int H = ffn_h(half), a0 = ffn_a0(half), CH = H / 8;
  const int item = u * 256 + tid;
  if (item >= 4096 * CH) return;
  const int seg = item / CH, ch = item % CH;
  const int t0 = seg * 8;
  const int f = ch * 8;
  const int ca = a0 + f, cv = 2816 + a0 + f;
  const long us = 2 * H;
  const u16* uh = (const u16*)(p.ws + OFF_UH);
  u16* hact = (u16*)(p.ws + OFF_HACT);
  const bool has_prev = (t0 & 4095) != 0, has_next = ((t0 + 8) & 4095) != 0;
  const u32x4 z = {0u, 0u, 0u, 0u};
  u32x4 ra[10], rv[10];
#pragma unroll
  for (int i = 0; i < 10; ++i) {
    const bool ok = (i == 0) ? has_prev : ((i == 9) ? has_next : true);
    const long tr = ok ? (long)(t0 - 1 + i) : (long)t0;
    ra[i] = __builtin_nontemporal_load((const u32x4*)(uh + tr * us + f));
    rv[i] = __builtin_nontemporal_load((const u32x4*)(uh + tr * us + H + f));
    if (!ok) { ra[i] = z; rv[i] = z; }
  }
  float wa[3][8], wv[3][8], ba[8], bv[8];
#pragma unroll
  for (int i = 0; i < 3; ++i)
#pragma unroll
    for (int q = 0; q < 8; ++q) {
      wa[i][q] = p.conv_w[i * 5632 + ca + q];
      wv[i][q] = p.conv_w[i * 5632 + cv + q];
    }
#pragma unroll
  for (int q = 0; q < 8; ++q) { ba[q] = p.conv_b[ca + q]; bv[q] = p.conv_b[cv + q]; }
#pragma unroll
  for (int i = 0; i < 8; ++i) {
    unsigned o[4];
#pragma unroll
    for (int q = 0; q < 4; ++q) {
      float a_lo = bf2f((u16)(ra[i][q] & 0xffffu)) * wa[0][2 * q] + bf2f((u16)(ra[i + 1][q] & 0xffffu)) * wa[1][2 * q] + bf2f((u16)(ra[i + 2][q] & 0xffffu)) * wa[2][2 * q] + ba[2 * q];
      float a_hi = bf2f((u16)(ra[i][q] >> 16)) * wa[0][2 * q + 1] + bf2f((u16)(ra[i + 1][q] >> 16)) * wa[1][2 * q + 1] + bf2f((u16)(ra[i + 2][q] >> 16)) * wa[2][2 * q + 1] + ba[2 * q + 1];
      float v_lo = bf2f((u16)(rv[i][q] & 0xffffu)) * wv[0][2 * q] + bf2f((u16)(rv[i + 1][q] & 0xffffu)) * wv[1][2 * q] + bf2f((u16)(rv[i + 2][q] & 0xffffu)) * wv[2][2 * q] + bv[2 * q];
      float v_hi = bf2f((u16)(rv[i][q] >> 16)) * wv[0][2 * q + 1] + bf2f((u16)(rv[i + 1][q] >> 16)) * wv[1][2 * q + 1] + bf2f((u16)(rv[i + 2][q] >> 16)) * wv[2][2 * q + 1] + bv[2 * q + 1];
      o[q] = pack2(siluf_(a_lo) * v_lo, siluf_(a_hi) * v_hi);
    }
    *(u32x4*)(hact + (long)(t0 + i) * 2816 + a0 + f) = u32x4{o[0], o[1], o[2], o[3]};
  }
}
__device__ __forceinline__ int act_units(int half) { return 4096 * (ffn_h(half) / 8) / 256; }

__device__ __forceinline__ GA down_ga(const Params& p, int half, int id) {
  const int H = 2816, a0 = 0; (void)half;
  GA g; g.A = nullptr; g.B = nullptr; g.lda = H; g.ldb = 2816;
  if (id < 512) {
    int mt_, nt_;
    tile_mn(id, 4, mt_, nt_);
    g.A = (const u16*)(p.ws + OFF_HACT) + (long)mt_ * 256 * H;
    g.B = (const u16*)(p.ws + OFF_WDOWN) + (long)nt_ * 256 * 2816 + a0;
  }
  return g;
}
__device__ __forceinline__ void down_tile(const Params& p, int half, int id, char* smem, bool pre, GA nx) {
  const int H = 2816, a0 = 0; (void)half;
  int mt_, nt_;
  tile_mn(id, 4, mt_, nt_);
  const int m0 = mt_ * 256, n0 = nt_ * 256;
  EPI_IDS;
  f32x4 acc[8][4];
  zero_acc(acc);
  gemm256<true>(acc, (const u16*)(p.ws + OFF_HACT) + (long)m0 * H, H, (const u16*)(p.ws + OFF_WDOWN) + (long)n0 * 2816 + a0, 2816, H, smem, pre, nx);
  const float* mod = (const float*)(p.ws + OFF_MOD);
  const int bb = m0 >> 12;
  F32_EPILOGUE({
    const long off = (long)(m0 + rt) * 1024 + n0 + ct;
    f32x4 xv = __builtin_nontemporal_load((const f32x4*)(p.out + off));
    float4 gv = *(const float4*)(mod + bb * 6144 + 5120 + n0 + ct);
    xv[0] += gv.x * a4[0];
    xv[1] += gv.y * a4[1];
    xv[2] += gv.z * a4[2];
    xv[3] += gv.w * a4[3];
    __builtin_nontemporal_store(xv, (f32x4*)(p.out + off));
  })
}

#define XB_TMO      128
#define XB_XCNT(j)  (256  + 64 * (j))
#define XB_XSUB(j)  (1280 + 64 * (j))
#define XB_XGEN(j)  (2304 + 64 * (j))
#define XB_TOP      3328
#define XB_TOPGEN   3392
#define XCD_BAR_WORDS 3456
#define XB_SPIN_CAP (1u << 18)
#define LAS __attribute__((address_space(3)))

__device__ __forceinline__ unsigned xb_ld(unsigned* p)              { return __hip_atomic_load(p, __ATOMIC_RELAXED, __HIP_MEMORY_SCOPE_AGENT); }
__device__ __forceinline__ unsigned xb_add(unsigned* p, unsigned v) { return __hip_atomic_fetch_add(p, v, __ATOMIC_RELAXED, __HIP_MEMORY_SCOPE_AGENT); }
__device__ __forceinline__ unsigned xb_xcc_id() { return (unsigned)__builtin_amdgcn_s_getreg((3 << 11) | 20) & 0xFu; }
#define XB_SPIN(cond, bar) do { unsigned _sp = 0; while (cond) { __builtin_amdgcn_s_sleep(1); \
    if ((++_sp & 255u) == 0u) { if (xb_ld(&(bar)[XB_TMO])) break; if (_sp > XB_SPIN_CAP) { atomicAdd(&(bar)[XB_TMO], 1u); break; } } } } while (0)

struct XcdBarrier {
    unsigned* bar; unsigned x;
    volatile LAS unsigned* st;
};

__device__ __forceinline__ XcdBarrier xcd_barrier_post(unsigned* bar, volatile LAS unsigned* st) {
    XcdBarrier b; b.bar = bar; b.x = xb_xcc_id(); b.st = st;
    if (threadIdx.x == 0) (void)xb_add(&bar[XB_XCNT(b.x)], 1u);
    return b;
}
__device__ __forceinline__ void xcd_barrier_complete(unsigned* bar, unsigned x, unsigned& nloc, unsigned& nx) {
    const unsigned G = gridDim.x * gridDim.y * gridDim.z;
    unsigned sum, cnt, mine, sp = 0u;
    for (;;) {
        sum = 0u; cnt = 0u; mine = 0u;
#pragma unroll
        for (unsigned j = 0; j < 16; ++j) { const unsigned c = xb_ld(&bar[XB_XCNT(j)]); sum += c; cnt += (c > 0u) ? 1u : 0u; mine = (j == x) ? c : mine; }
        if (sum == G) break;
        __builtin_amdgcn_s_sleep(1);
        if ((++sp & 255u) == 0u) { if (xb_ld(&bar[XB_TMO])) break; if (sp > XB_SPIN_CAP) { atomicAdd(&bar[XB_TMO], 1u); break; } }
    }
    nloc = mine > 0u ? mine : 1u; nx = cnt > 0u ? cnt : 1u;
}

__device__ __forceinline__ void xcd_barrier(const XcdBarrier& b) {
    asm volatile("s_waitcnt vmcnt(0)" ::: "memory");
    __syncthreads();
    if (threadIdx.x == 0) {
        unsigned* bar = b.bar;
        __builtin_amdgcn_s_waitcnt(0);
        unsigned nloc = b.st[0], nx = b.st[1];
        if (nloc == 0u) { xcd_barrier_complete(bar, b.x, nloc, nx); b.st[0] = nloc; b.st[1] = nx; }
        const unsigned old = xb_add(&bar[XB_XSUB(b.x)], 1u);
        const unsigned gen = old / nloc;
        if (old + 1u == (gen + 1u) * nloc) {
            __builtin_amdgcn_fence(__ATOMIC_RELEASE, "agent");
            asm volatile("s_waitcnt vmcnt(0)" ::: "memory");
            const unsigned og = xb_add(&bar[XB_TOP], 1u);
            const unsigned tg = og / nx;
            if (og + 1u == (tg + 1u) * nx) xb_add(&bar[XB_TOPGEN], 1u);
            else XB_SPIN(xb_ld(&bar[XB_TOPGEN]) == tg, bar);
            __builtin_amdgcn_fence(__ATOMIC_ACQUIRE, "agent");
            xb_add(&bar[XB_XGEN(b.x)], 1u);
            asm volatile("s_waitcnt vmcnt(0)" ::: "memory");
        } else {
            XB_SPIN(xb_ld(&bar[XB_XGEN(b.x)]) == gen, bar);
            __builtin_amdgcn_fence(__ATOMIC_ACQUIRE, "agent");
            asm volatile("s_waitcnt vmcnt(0)" ::: "memory");
        }
    }
    __syncthreads();
}


__global__ void __launch_bounds__(512, 2) mega(Params pk) {
  extern __shared__ __attribute__((aligned(1024))) char smem[];
  Params& p_sh = *(Params*)(smem + PARAM_OFF);
  if (threadIdx.x == 0) {
    p_sh.x = pk.x; p_sh.c = pk.c; p_sh.ctx = pk.ctx; p_sh.c_ctx = pk.c_ctx; p_sh.w_ada = pk.w_ada; p_sh.b_ada = pk.b_ada;
    p_sh.norm1_g = pk.norm1_g; p_sh.w_in = pk.w_in; p_sh.na_rpb = pk.na_rpb; p_sh.ldf = pk.ldf; p_sh.ldb = pk.ldb;
    p_sh.w_pna = pk.w_pna; p_sh.w_pret = pk.w_pret; p_sh.w_out = pk.w_out; p_sh.norm2_g = pk.norm2_g; p_sh.w_up = pk.w_up;
    p_sh.conv_w = pk.conv_w; p_sh.conv_b = pk.conv_b; p_sh.w_down = pk.w_down; p_sh.final_g = pk.final_g;
    p_sh.out = pk.out; p_sh.ws = pk.ws;
  }
  volatile LAS unsigned* xb_st = (volatile LAS unsigned*)(smem + PARAM_OFF + 192);
  if (threadIdx.x == 0) { xb_st[0] = 0u; xb_st[1] = 0u; }
  unsigned* xb_bar = (unsigned*)(pk.ws + WS_END);
  if (blockIdx.x == 0) for (int i = threadIdx.x; i < XCD_BAR_WORDS; i += 512) xb_bar[i] = 0u;
  __syncthreads();
  const Params& p = p_sh;
  cg::grid_group grid = cg::this_grid();
  const int nb = gridDim.x, bid = blockIdx.x;
#define VB_IDS                                                                        \
  int tid_ = threadIdx.x; asm volatile("" : "+v"(tid_));                              \
  const int hb = tid_ >> 8, vtid = tid_ & 255, vb = bid * 2 + hb, nvb = nb * 2, w8 = tid_ >> 6; \
  char* hsm = smem + hb * HALF_LDS;                                                   \
  const float* mod = (const float*)(p.ws + OFF_MOD);                                  \
  (void)vtid; (void)vb; (void)nvb; (void)w8; (void)hsm; (void)mod
#define GSYNC()                                                                       \
  do {                                                                                \
    XcdBarrier b_;                                                                    \
    b_.bar = (unsigned*)(p.ws + WS_END);                                              \
    b_.st = (volatile LAS unsigned*)(smem + PARAM_OFF + 192);                         \
    b_.x = b_.st[2];                                                                  \
    xcd_barrier(b_);                                                                  \
  } while (0)

  { VB_IDS; for (int u = vb; u < P0_UNITS; u += nvb) p0_unit(p, u, hsm, vtid); }
  grid.sync();
  {
    const XcdBarrier xb0 = xcd_barrier_post((unsigned*)(p.ws + WS_END), (volatile LAS unsigned*)(smem + PARAM_OFF + 192));
    if (threadIdx.x == 0) ((volatile LAS unsigned*)(smem + PARAM_OFF + 192))[2] = xb0.x;
    __syncthreads();
  }
  for (int u = bid; u < (T + TC) / 16; u += nb) {
    VB_IDS;
    int row = u * 16 + w8 * 2;
    if (row < T) {
      int b = row >> 12;
      rownorm2_bf16(p.x + (long)row * 1024, p.norm1_g, mod + b * 6144, mod + b * 6144 + 1024, (u16*)(p.ws + OFF_HX) + (long)row * 1024);
    } else {
      rownorm2_bf16(p.ctx + (long)(row - T) * 1024, p.norm1_g, mod + 8 * 6144, mod + 8 * 6144 + 1024, (u16*)(p.ws + OFF_HX) + (long)row * 1024);
    }
  }
  GSYNC();
  {
    bool pre = false;
    for (int u = bid; u < 2304 + 80; u += nb) { GA nx = inproj_ga(p, 1 << 30); inproj_tile(p, u, smem, pre, nx); pre = false; }
  }
  GSYNC();
  {
    VB_IDS;
    if (nb == 256) {
      if (bid < 128) {
        scan_unit(p, vb, hsm, vtid);
        na_run(p, 2816 + bid * 10 + hb, 2, 5, hsm, vtid);
      } else {
        na_run(p, (bid - 128) * 22 + hb, 2, 11, hsm, vtid);
      }
    } else {
      for (int u = vb; u < 256; u += nvb) scan_unit(p, u, hsm, vtid);
      int cnt = (4096 - vb + nvb - 1) / nvb;
      na_run(p, vb, nvb, cnt, hsm, vtid);
    }
  }
  GSYNC();
  { VB_IDS; for (int u = vb; u < 1024; u += nvb) intra_unit(p, u, hsm, vtid); }
  GSYNC();
  {
    bool pre = false;
    for (int u = bid; u < 512; u += nb) {
      int mt_, nt_;
      tile_mn(u, 4, mt_, nt_);
      const int m0 = mt_ * 256, n0 = nt_ * 256;
      GA nx; nx.A = nullptr; nx.B = nullptr; nx.lda = 1024; nx.ldb = 1024;
      merge_step<0>(p, m0, n0, smem, false, nx);
      merge_step<1>(p, m0, n0, smem, false, nx);
      merge_step<2>(p, m0, n0, smem, false, nx);
      merge_step<3>(p, m0, n0, smem, false, nx);
      (void)pre;
    }
  }
  GSYNC();
  {
    bool pre = false;
    for (int u = bid; u < 512; u += nb) { GA nx = outproj_ga(p, 1 << 30); outproj_tile(p, u, smem, pre, nx); pre = false; }
  }
  GSYNC();
  for (int u = bid; u < T / 16; u += nb) {
    VB_IDS;
    int row = u * 16 + w8 * 2;
    int b = row >> 12;
    rownorm2_bf16(p.out + (long)row * 1024, p.norm2_g, mod + b * 6144 + 3072, mod + b * 6144 + 4096, (u16*)(p.ws + OFF_HX) + (long)row * 1024);
  }
  GSYNC();
  {
    bool pre = false;
    for (int u = bid; u < 128 * 12; u += nb) { GA nx = up_ga(p, 0, 1 << 30); up_tile(p, 0, u, smem, pre, nx); pre = false; }
  }
  GSYNC();
  { VB_IDS; for (int u = vb; u < act_units(0); u += nvb) act_unit(p, 0, u, vtid); }
  GSYNC();
  {
    bool pre = false;
    for (int u = bid; u < 128 * 10; u += nb) { GA nx = up_ga(p, 1, 1 << 30); up_tile(p, 1, u, smem, pre, nx); pre = false; }
  }
  GSYNC();
  { VB_IDS; for (int u = vb; u < act_units(1); u += nvb) act_unit(p, 1, u, vtid); }
  GSYNC();
  {
    bool pre = false;
    for (int u = bid; u < 512; u += nb) { GA nx = down_ga(p, 1, 1 << 30); down_tile(p, 1, u, smem, pre, nx); pre = false; }
  }
  GSYNC();
  for (int u = bid; u < T / 16; u += nb) {
    VB_IDS;
    int row = u * 16 + w8 * 2;
    const int lane = tid_ & 63;
    float* src = p.out + (long)row * 1024;
    float4 v[2][4];
#pragma unroll
    for (int r = 0; r < 2; ++r)
#pragma unroll
      for (int i = 0; i < 4; ++i) {
        const f32x4 t4 = __builtin_nontemporal_load((const f32x4*)(src + r * 1024) + lane + i * 64);
        v[r][i].x = t4[0]; v[r][i].y = t4[1]; v[r][i].z = t4[2]; v[r][i].w = t4[3];
      }
    float ss0 = 0.f, ss1 = 0.f;
#pragma unroll
    for (int i = 0; i < 4; ++i) {
      ss0 += v[0][i].x * v[0][i].x + v[0][i].y * v[0][i].y + v[0][i].z * v[0][i].z + v[0][i].w * v[0][i].w;
      ss1 += v[1][i].x * v[1][i].x + v[1][i].y * v[1][i].y + v[1][i].z * v[1][i].z + v[1][i].w * v[1][i].w;
    }
    ss0 = wave_sum(ss0);
    ss1 = wave_sum(ss1);
    const float r0 = rsqrtf(ss0 * (1.f / 1024.f) + 1e-6f), r1 = rsqrtf(ss1 * (1.f / 1024.f) + 1e-6f);
#pragma unroll
    for (int i = 0; i < 4; ++i) {
      float4 gn = ((const float4*)p.final_g)[lane + i * 64];
      float4 o0, o1;
      o0.x = v[0][i].x * r0 * gn.x; o0.y = v[0][i].y * r0 * gn.y; o0.z = v[0][i].z * r0 * gn.z; o0.w = v[0][i].w * r0 * gn.w;
      o1.x = v[1][i].x * r1 * gn.x; o1.y = v[1][i].y * r1 * gn.y; o1.z = v[1][i].z * r1 * gn.z; o1.w = v[1][i].w * r1 * gn.w;
      __builtin_nontemporal_store(f32x4{o0.x, o0.y, o0.z, o0.w}, (f32x4*)src + lane + i * 64);
      __builtin_nontemporal_store(f32x4{o1.x, o1.y, o1.z, o1.w}, (f32x4*)(src + 1024) + lane + i * 64);
    }
  }
}

extern "C" void kernel_launch(void* const* d_in, const int* in_sizes, int n_in, void* d_out, int out_size, void* d_ws,
                              size_t ws_size, hipStream_t stream) {
  static int grid_blocks = 0;
  if (grid_blocks == 0) {
    if (n_in != 20 || ws_size < (size_t)WS_END + 16384 || out_size != T * 1024) {
      fprintf(stderr, "kernel_launch: unexpected sizes n_in=%d ws=%zu out=%d (need ws >= %ld)\n", n_in, ws_size, out_size, (long)WS_END);
      grid_blocks = -1;
      return;
    }
    int dev = 0, cus = 0, per_cu = 0;
    hipGetDevice(&dev);
    hipDeviceGetAttribute(&cus, hipDeviceAttributeMultiprocessorCount, dev);
    hipFuncSetAttribute((const void*)mega, hipFuncAttributeMaxDynamicSharedMemorySize, LDS_BYTES);
    hipOccupancyMaxActiveBlocksPerMultiprocessor(&per_cu, (const void*)mega, 512, LDS_BYTES);
    if (per_cu < 1) per_cu = 1;
    if (per_cu > 1) per_cu = 1;
    grid_blocks = cus * per_cu;
    fprintf(stderr, "kernel_launch: cus=%d per_cu=%d grid=%d\n", cus, per_cu, grid_blocks);
  }
  if (grid_blocks < 0) return;
  Params p{};
  p.x = (const float*)d_in[0]; p.c = (const float*)d_in[1]; p.ctx = (const float*)d_in[2]; p.c_ctx = (const float*)d_in[3];
  p.w_ada = (const float*)d_in[4]; p.b_ada = (const float*)d_in[5]; p.norm1_g = (const float*)d_in[6]; p.w_in = (const float*)d_in[7];
  p.na_rpb = (const float*)d_in[8]; p.ldf = (const float*)d_in[9]; p.ldb = (const float*)d_in[10]; p.w_pna = (const float*)d_in[11];
  p.w_pret = (const float*)d_in[12]; p.w_out = (const float*)d_in[13]; p.norm2_g = (const float*)d_in[14]; p.w_up = (const float*)d_in[15];
  p.conv_w = (const float*)d_in[16]; p.conv_b = (const float*)d_in[17]; p.w_down = (const float*)d_in[18]; p.final_g = (const float*)d_in[19];
  p.out = (float*)d_out;
  p.ws = (char*)d_ws;
  void* args[] = {&p};
  hipError_t e = hipLaunchCooperativeKernel((const void*)mega, dim3(grid_blocks), dim3(512), args, LDS_BYTES, stream);
  if (e != hipSuccess) fprintf(stderr, "cooperative launch failed: %s (grid %d)\n", hipGetErrorString(e), grid_blocks);
}
```
